# Optimizing an MI355X kernel written in HIP

```python
import math
import jax, jax.numpy as jnp
from jax import lax
import numpy as np

D_MODEL = 1024
BATCH = 16
SEQ = 4096
DEPTH = 2

HEAD_DIM = 64
SWA_HEADS = 4
SWA_KV_HEADS = 2
SWA_WINDOW = 128
SWA_BLOCK = 128
MOBA_HEADS = 4
MOBA_BLOCK = 256
MOBA_TOPK = 3
MOBA_Q_CHUNK = 64
SB_HEADS = 4
SB_Q_BLOCK = 128
RET_HEADS = 4
RET_CHUNK = 128
D_FF = 4 * D_MODEL
ROPE_THETA = 10000.0
LN_EPS = 1e-5
NEG = -1e30
DEEPNORM_ALPHA = (2 * DEPTH) ** 0.25
DEEPNORM_BETA = (8 * DEPTH) ** -0.25

IN_SPLIT_SIZES = (
    SWA_HEADS * HEAD_DIM, SWA_KV_HEADS * HEAD_DIM, SWA_KV_HEADS * HEAD_DIM,
    MOBA_HEADS * HEAD_DIM, MOBA_HEADS * HEAD_DIM, MOBA_HEADS * HEAD_DIM,
    SB_HEADS * HEAD_DIM, SB_HEADS * HEAD_DIM, SB_HEADS * HEAD_DIM,
    RET_HEADS * HEAD_DIM, RET_HEADS * HEAD_DIM, RET_HEADS * HEAD_DIM, RET_HEADS * HEAD_DIM,
)
IN_IS_VALUE = (False, False, True, False, False, True, False, False, True, False, False, True, False)
IN_WIDTH = sum(IN_SPLIT_SIZES)
MIX_WIDTH = (SWA_HEADS + MOBA_HEADS + SB_HEADS + RET_HEADS) * HEAD_DIM

kernel_name = "hymba_style_four_mixer_deepnorm_block"


def layer_norm(x, w, b):
    xf = x.astype(jnp.float32)
    mu = jnp.mean(xf, -1, keepdims=True)
    var = jnp.mean(jnp.square(xf - mu), -1, keepdims=True)
    return ((xf - mu) * lax.rsqrt(var + LN_EPS) * w + b).astype(x.dtype)


def rope(x):
    s, d = x.shape[1], x.shape[-1]
    inv = 1.0 / (ROPE_THETA ** (jnp.arange(0, d, 2, dtype=jnp.float32) / d))
    ang = jnp.arange(s, dtype=jnp.float32)[:, None] * inv[None, :]
    cos = jnp.cos(ang)[None, :, None, :]
    sin = jnp.sin(ang)[None, :, None, :]
    x1, x2 = x[..., : d // 2], x[..., d // 2:]
    return jnp.concatenate([x1 * cos - x2 * sin, x1 * sin + x2 * cos], -1).astype(x.dtype)


def swa_sink_attention(q, k, v, sinks):
    b, s, hq, d = q.shape
    hkv = k.shape[2]
    g = hq // hkv
    w = SWA_BLOCK
    nb = s // w
    qb = q.reshape(b, nb, w, hkv, g, d)
    kb = k.reshape(b, nb, w, hkv, d)
    vb = v.reshape(b, nb, w, hkv, d)
    kk = jnp.concatenate([jnp.concatenate([jnp.zeros_like(kb[:, :1]), kb[:, :-1]], 1), kb], 2)
    vv = jnp.concatenate([jnp.concatenate([jnp.zeros_like(vb[:, :1]), vb[:, :-1]], 1), vb], 2)
    logits = jnp.einsum('bnqhgd,bnkhd->bnhgqk', qb, kk, preferred_element_type=jnp.float32) * (d ** -0.5)
    blk = jnp.arange(nb)[:, None, None]
    qabs = blk * w + jnp.arange(w)[None, :, None]
    kabs = blk * w + jnp.arange(2 * w)[None, None, :] - w
    mask = (kabs >= 0) & (kabs <= qabs) & (qabs - kabs < SWA_WINDOW)
    logits = jnp.where(mask[None, :, None, None], logits, NEG)
    sink = jnp.broadcast_to(sinks.astype(jnp.float32).reshape(1, 1, hkv, g, 1, 1), logits.shape[:-1] + (1,))
    probs = jax.nn.softmax(jnp.concatenate([logits, sink], -1), axis=-1)[..., :-1]
    out = jnp.einsum('bnhgqk,bnkhd->bnqhgd', probs.astype(v.dtype), vv)
    return out.reshape(b, s, hq, d)


def moba_attention(q, k, v):
    b, s, h, d = q.shape
    lb = MOBA_BLOCK
    sp = ((s + lb - 1) // lb) * lb
    pad = ((0, 0), (0, sp - s), (0, 0), (0, 0))
    qp, kp, vp = jnp.pad(q, pad), jnp.pad(k, pad), jnp.pad(v, pad)
    nb = sp // lb
    k_sel = min(MOBA_TOPK, nb - 1)
    kblk_t = kp.reshape(b, nb, lb, h, d).transpose(0, 3, 1, 2, 4)
    vblk_t = vp.reshape(b, nb, lb, h, d).transpose(0, 3, 1, 2, 4)
    kmean = jnp.mean(kblk_t.astype(jnp.float32), axis=3)
    scale = d ** -0.5
    bi = jnp.arange(b)[:, None, None, None]
    hi = jnp.arange(h)[None, :, None, None]
    nq = MOBA_Q_CHUNK

    def chunk_fn(c):
        start = c * nq
        own = start // lb
        qc = lax.dynamic_slice_in_dim(qp, start, nq, axis=1)
        qpos = start + jnp.arange(nq)
        kpos = own * lb + jnp.arange(lb)
        own_k = lax.dynamic_slice_in_dim(kp, own * lb, lb, axis=1)
        own_v = lax.dynamic_slice_in_dim(vp, own * lb, lb, axis=1)
        s_own = jnp.einsum('bqhd,blhd->bhql', qc, own_k, preferred_element_type=jnp.float32) * scale
        s_own = jnp.where(kpos[None, :] <= qpos[:, None], s_own, NEG)
        if k_sel == 0:
            p = jax.nn.softmax(s_own, axis=-1)
            return jnp.einsum('bhql,blhd->bqhd', p.astype(v.dtype), own_v)
        gate = jnp.einsum('bqhd,bhnd->bhqn', qc.astype(jnp.float32), kmean)
        gate = jnp.where(jnp.arange(nb) < own, gate, -jnp.inf)
        _, top_i = lax.top_k(gate, k_sel)
        sel_valid = top_i < own
        kg = kblk_t[bi, hi, top_i]
        vg = vblk_t[bi, hi, top_i]
        s_sel = jnp.einsum('bqhd,bhqkld->bhqkl', qc, kg, preferred_element_type=jnp.float32) * scale
        s_sel = jnp.where(sel_valid[..., None], s_sel, NEG).reshape(b, h, nq, k_sel * lb)
        p = jax.nn.softmax(jnp.concatenate([s_sel, s_own], -1), axis=-1).astype(v.dtype)
        p_sel = p[..., : k_sel * lb].reshape(b, h, nq, k_sel, lb)
        p_own = p[..., k_sel * lb:]
        return (jnp.einsum('bhqkl,bhqkld->bqhd', p_sel, vg)
                + jnp.einsum('bhql,blhd->bqhd', p_own, own_v))

    outs = lax.map(chunk_fn, jnp.arange(sp // nq))
    return outs.transpose(1, 0, 2, 3, 4).reshape(b, sp, h, d)[:, :s]


def stick_breaking_attention(q, k, v):
    b, s, h, d = q.shape
    nq = SB_Q_BLOCK
    kpos = jnp.arange(s)

    def block_fn(c):
        start = c * nq
        qc = lax.dynamic_slice_in_dim(q, start, nq, axis=1)
        z = jnp.einsum('bqhd,bkhd->bhqk', qc, k, preferred_element_type=jnp.float32) * (d ** -0.5)
        qpos = start + jnp.arange(nq)
        mask = kpos[None, :] < qpos[:, None]
        log_fail = jnp.where(mask, jax.nn.log_sigmoid(-z), 0.0)
        after = lax.cumsum(log_fail, axis=3, reverse=True) - log_fail
        a = jnp.where(mask, jnp.exp(jax.nn.log_sigmoid(z) + after), 0.0)
        return jnp.einsum('bhqk,bkhd->bqhd', a.astype(v.dtype), v)

    outs = lax.map(block_fn, jnp.arange(s // nq))
    return outs.transpose(1, 0, 2, 3, 4).reshape(b, s, h, d)


def retention_chunkwise(q, k, v):
    b, s, h, d = q.shape
    c = RET_CHUNK
    n = s // c
    log_g = jnp.log(1.0 - 2.0 ** (-5.0 - jnp.arange(h, dtype=jnp.float32)))
    idx = jnp.arange(c, dtype=jnp.float32)
    diff = idx[:, None] - idx[None, :]
    decay_in = jnp.where(diff >= 0, jnp.exp(jnp.maximum(diff, 0.0)[None] * log_g[:, None, None]), 0.0)
    qc = q.astype(jnp.float32).reshape(b, n, c, h, d)
    kc = (k.astype(jnp.float32) * (d ** -0.5)).reshape(b, n, c, h, d)
    vc = v.astype(jnp.float32).reshape(b, n, c, h, d)
    inner_s = jnp.einsum('bnihd,bnjhd->bnhij', qc, kc) * decay_in[None, None]
    inner = jnp.einsum('bnhij,bnjhe->bnihe', inner_s, vc)
    k_w = jnp.exp((c - 1.0 - idx)[:, None] * log_g[None, :])
    kv = jnp.einsum('bnjhd,bnjhe->nbhde', kc * k_w[None, None, :, :, None], vc)
    g_c = jnp.exp(c * log_g)[None, :, None, None]

    def step(state, kv_n):
        return state * g_c + kv_n, state

    _, states = lax.scan(step, jnp.zeros((b, h, d, d), jnp.float32), kv)
    q_w = jnp.exp((idx + 1.0)[:, None] * log_g[None, :])
    cross = jnp.einsum('bnihd,nbhde->bnihe', qc * q_w[None, None, :, :, None], states)
    return (inner + cross).reshape(b, s, h, d)


def head_group_norm(y):
    yf = y.astype(jnp.float32)
    mu = jnp.mean(yf, -1, keepdims=True)
    var = jnp.mean(jnp.square(yf - mu), -1, keepdims=True)
    return (yf - mu) * lax.rsqrt(var + LN_EPS)


def hybrid_layer(x, w_in, sinks, w_out, ln1_w, ln1_b, w_up, w_down, ln2_w, ln2_b):
    b, s, _ = x.shape
    proj = x @ w_in
    points, acc = [], 0
    for n_cols in IN_SPLIT_SIZES[:-1]:
        acc += n_cols
        points.append(acc)
    aq, ak, av, bq, bk, bv, cq, ck, cv, dq, dk, dv, dg = jnp.split(proj, points, axis=-1)
    heads = lambda t: t.reshape(b, s, -1, HEAD_DIM)
    ya = swa_sink_attention(rope(heads(aq)), rope(heads(ak)), heads(av), sinks)
    yb = moba_attention(rope(heads(bq)), rope(heads(bk)), heads(bv))
    yc = stick_breaking_attention(heads(cq), heads(ck), heads(cv))
    yd = retention_chunkwise(rope(heads(dq)), rope(heads(dk)), heads(dv))
    yd = (head_group_norm(yd).reshape(b, s, -1) * jax.nn.silu(dg.astype(jnp.float32))).astype(x.dtype)
    mixed = jnp.concatenate([ya.reshape(b, s, -1).astype(x.dtype), yb.reshape(b, s, -1).astype(x.dtype),
                             yc.reshape(b, s, -1).astype(x.dtype), yd], axis=-1)
    x = layer_norm(DEEPNORM_ALPHA * x + mixed @ w_out, ln1_w, ln1_b)
    hid = jnp.square(jax.nn.relu(x @ w_up))
    return layer_norm(DEEPNORM_ALPHA * x + hid @ w_down, ln2_w, ln2_b)


def setup_inputs(seed: int = 0) -> dict:
    key = jax.random.key(seed)
    ks = jax.random.split(key, 11)
    x = jax.random.normal(ks[0], (BATCH, SEQ, D_MODEL), jnp.float32)
    col_scale = jnp.concatenate([jnp.full((n_cols,), DEEPNORM_BETA if is_v else 1.0, jnp.float32)
                                 for n_cols, is_v in zip(IN_SPLIT_SIZES, IN_IS_VALUE)])
    w_in = jax.random.normal(ks[1], (DEPTH, D_MODEL, IN_WIDTH), jnp.float32) * (D_MODEL ** -0.5) * col_scale
    swa_sinks = 0.5 * jax.random.normal(ks[2], (DEPTH, SWA_HEADS), jnp.float32)
    w_out = jax.random.normal(ks[3], (DEPTH, MIX_WIDTH, D_MODEL), jnp.float32) * (MIX_WIDTH ** -0.5) * DEEPNORM_BETA
    ln1_w = 1.0 + 0.02 * jax.random.normal(ks[4], (DEPTH, D_MODEL), jnp.float32)
    ln1_b = 0.02 * jax.random.normal(ks[5], (DEPTH, D_MODEL), jnp.float32)
    w_up = jax.random.normal(ks[6], (DEPTH, D_MODEL, D_FF), jnp.float32) * (D_MODEL ** -0.5)
    w_down = jax.random.normal(ks[7], (DEPTH, D_FF, D_MODEL), jnp.float32) * (D_FF ** -0.5) * DEEPNORM_BETA
    ln2_w = 1.0 + 0.02 * jax.random.normal(ks[8], (DEPTH, D_MODEL), jnp.float32)
    ln2_b = 0.02 * jax.random.normal(ks[9], (DEPTH, D_MODEL), jnp.float32)
    return {"x": x, "w_in": w_in, "swa_sinks": swa_sinks, "w_out": w_out, "ln1_w": ln1_w, "ln1_b": ln1_b,
            "w_up": w_up, "w_down": w_down, "ln2_w": ln2_w, "ln2_b": ln2_b}


def reference(x, w_in, swa_sinks, w_out, ln1_w, ln1_b, w_up, w_down, ln2_w, ln2_b):
    for layer in range(DEPTH):
        x = hybrid_layer(x, w_in[layer], swa_sinks[layer], w_out[layer], ln1_w[layer], ln1_b[layer],
                         w_up[layer], w_down[layer], ln2_w[layer], ln2_b[layer])
    return x
```

```cpp
#include <hip/hip_runtime.h>
#include <cstdio>
#include <cstdint>
namespace pg8 {
#define PG8_LAS __attribute__((address_space(3)))
typedef unsigned short bf16_t;
typedef short bf16x8 __attribute__((ext_vector_type(8)));
typedef float f32x4 __attribute__((ext_vector_type(4)));
typedef unsigned u32x4 __attribute__((ext_vector_type(4)));
constexpr int BM = 256, BK = 64, HALF = 128, HTB = HALF * BK * 2  , STAGE_BYTES = 8 * HTB, NXCD = 8, WGM = 8;

__host__ __device__ __forceinline__ int lds_byte(int r, int c) { const int st = (r >> 4) * 2 + (c >> 5), rr = r & 15, cc = c & 31, ob = rr * 64 + cc * 2; return st * 1024 + (ob ^ (((ob >> 9) & 1) << 5)); }
__host__ __device__ __forceinline__ void stage_rc(int b, int& R, int& C) { const int st = b / 1024, sb = b % 1024, swz = sb ^ (((sb >> 9) & 1) << 5); R = (st >> 1) * 16 + swz / 64; C = (st & 1) * 32 + (swz % 64) / 2; }
__host__ __device__ __forceinline__ int perm32(int rho) { const int n = rho >> 4, i = rho & 15; return 8 * (i >> 2) + 4 * n + (i & 3); }

struct Unit { int pm, pn; };
struct Gemm { const bf16_t* A; const bf16_t* Bt; int M, N, K; };

struct StaticOrder {
    int nM, nN, nwg, G, c;
    __host__ __device__ void init(int M, int N, int G_, int c_) { nM = M / BM; nN = N / BM; nwg = nM * nN; G = G_; c = c_; }
    __host__ __device__ bool next(int i, Unit& u) const {
        const long L = (long)i * G + c; if (L >= nwg) return false;
        int wgid = (int)L; { const int q = nwg / NXCD, r = nwg % NXCD, xcd = wgid % NXCD, off = wgid / NXCD; wgid = (xcd < r ? xcd * (q + 1) : r * (q + 1) + (xcd - r) * q) + off; }
        const int nig = WGM * nN, gid = wgid / nig, fm = gid * WGM, gsz = (nM - fm) < WGM ? (nM - fm) : WGM;
        u.pm = fm + ((wgid % nig) % gsz); u.pn = (wgid % nig) / gsz; return true;
    }
    __device__ __forceinline__ void a_ready(const Unit&) const {}
    __device__ __forceinline__ void done(const Unit&) const {}
};

__device__ __forceinline__ unsigned cvt_pk_bf16(float lo, float hi) { unsigned r; asm volatile("v_cvt_pk_bf16_f32 %0, %1, %2" : "=v"(r) : "v"(lo), "v"(hi)); return r; }
typedef float f32x2 __attribute__((ext_vector_type(2)));
typedef unsigned u32x2 __attribute__((ext_vector_type(2)));
constexpr float LN_EPS_F = 1e-5f;
constexpr size_t EPI_WS_COS = 1u << 20, EPI_WS_KPART = 2u << 20, EPI_WS_VEC = (2u << 20) + 512 * 1024, EPI_WS_PROJ = 320ull << 20, EPI_WS_HID = 320ull << 20;
constexpr int EPI_TAB_OFF = 131072;
constexpr float ALPHA_F = 1.41421356237309515f;
constexpr float QK_C2 = 0.125f * 1.4426950408889634f;
__device__ __forceinline__ void row_stats(const float* st, int row, float& mu, float& rs) {
    const f32x4 a = *(const f32x4*)(st + (size_t)row * 8), b = *(const f32x4*)(st + (size_t)row * 8 + 4);
    const float s = (a[0] + a[2]) + (b[0] + b[2]), q = (a[1] + a[3]) + (b[1] + b[3]);
    mu = s * (1.f / 1024.f); const float var = fmaxf(q * (1.f / 1024.f) - mu * mu, 0.f);
    rs = 1.0f / sqrtf(var + LN_EPS_F);
}
struct EpiIn {
    static constexpr bool PERM = false, AFTER_DRAIN = false;
    unsigned char* ws; const float* st; int l;
    __device__ __forceinline__ void operator()(const f32x4 (&acc)[2][2][4][2], const Unit& u, int wr, int wc, int fr, int fq) const {
        bf16_t* P = (bf16_t*)(ws + EPI_WS_PROJ); const float* cs = (const float*)(ws + EPI_WS_VEC) + l * 3072; const float* bb = cs + 2 * 3072;
        const float* cosT = (const float*)(ws + EPI_WS_COS); const float* sinT = cosT + 4096 * 32; float* kpart = (float*)(ws + EPI_WS_KPART);
        constexpr unsigned ROPE_M = (1u << 0) | (1u << 1) | (1u << 2) | (1u << 4) | (1u << 5) | (1u << 6) | (1u << 7) | (1u << 16) | (1u << 17) | (1u << 18) | (1u << 19);
        constexpr unsigned C2_M = (1u << 0) | (1u << 1) | (1u << 4) | (1u << 5) | (1u << 10) | (1u << 11);
        constexpr unsigned K8_M = (1u << 18) | (1u << 19);
        const int g0 = 2 * u.pn;
        const bool rope0 = (ROPE_M >> g0) & 1u, rope1 = (ROPE_M >> (g0 + 1)) & 1u;
        const float sc0 = ((C2_M >> g0) & 1u) ? QK_C2 : (((K8_M >> g0) & 1u) ? 0.125f : 1.f);
        const float sc1 = ((C2_M >> (g0 + 1)) & 1u) ? QK_C2 : (((K8_M >> (g0 + 1)) & 1u) ? 0.125f : 1.f);
        const int i0 = 16 * (wc & 1) + 4 * fq;
        const int jc = u.pn * BM + wc * 32 + 4 * fq;
        const bool fold = st != nullptr, km = (u.pn == 3);
        f32x4 csv[2][2], bbv[2][2];
#pragma unroll
        for (int bj = 0; bj < 2; ++bj)
#pragma unroll
            for (int n = 0; n < 2; ++n) { csv[bj][n] = fold ? *(const f32x4*)(cs + jc + bj * HALF + n * 16) : (f32x4){0.f, 0.f, 0.f, 0.f}; bbv[bj][n] = fold ? *(const f32x4*)(bb + jc + bj * HALF + n * 16) : (f32x4){0.f, 0.f, 0.f, 0.f}; }
        f32x4 ks[2][2];
#pragma unroll
        for (int bj = 0; bj < 2; ++bj) { ks[bj][0] = (f32x4){0.f, 0.f, 0.f, 0.f}; ks[bj][1] = (f32x4){0.f, 0.f, 0.f, 0.f}; }
#pragma unroll
        for (int ai = 0; ai < 2; ++ai)
#pragma unroll
            for (int m = 0; m < 4; ++m) {
                const int row = u.pm * BM + ai * HALF + wr * 64 + m * 16 + fr;
                float mu = 0.f, rs = 1.f; if (fold) row_stats(st, row, mu, rs);
                f32x4 c4 = (f32x4){1.f, 1.f, 1.f, 1.f}, s4 = (f32x4){0.f, 0.f, 0.f, 0.f};
                if (rope0 || rope1) { const int pos = row & 4095; c4 = *(const f32x4*)(cosT + pos * 32 + i0); s4 = *(const f32x4*)(sinT + pos * 32 + i0); }
#pragma unroll
                for (int bj = 0; bj < 2; ++bj) {
                    f32x4 x1 = acc[ai][bj][m][0], x2 = acc[ai][bj][m][1];
                    if (fold) { x1 = (x1 - mu * csv[bj][0]) * rs + bbv[bj][0]; x2 = (x2 - mu * csv[bj][1]) * rs + bbv[bj][1]; }
                    if (bj ? rope1 : rope0) { const f32x4 o1 = x1 * c4 - x2 * s4, o2 = x1 * s4 + x2 * c4; x1 = o1; x2 = o2; }
                    const float sc = bj ? sc1 : sc0; x1 = x1 * sc; x2 = x2 * sc;
                    if (km) { ks[bj][0] += x1; ks[bj][1] += x2; }
                    bf16_t* dst = P + (size_t)row * 3072 + u.pn * BM + bj * HALF + 64 * (wc >> 1) + i0;
                    u32x2 w1, w2; w1.x = cvt_pk_bf16(x1[0], x1[1]); w1.y = cvt_pk_bf16(x1[2], x1[3]); w2.x = cvt_pk_bf16(x2[0], x2[1]); w2.y = cvt_pk_bf16(x2[2], x2[3]);
                    *(u32x2*)dst = w1; *(u32x2*)(dst + 32) = w2;
                }
                if (m & 1) asm volatile("" ::: "memory");
            }
        if (km) {
#pragma unroll
            for (int bj = 0; bj < 2; ++bj)
#pragma unroll
                for (int n = 0; n < 2; ++n)
#pragma unroll
                    for (int e = 0; e < 4; ++e) { float v = ks[bj][n][e]; v += __shfl_xor(v, 1); v += __shfl_xor(v, 2); v += __shfl_xor(v, 4); v += __shfl_xor(v, 8); ks[bj][n][e] = v; }
            if (fr == 0) {
                float* kp = kpart + (size_t)(u.pm * 2 + wr) * 256 + 64 * (wc >> 1) + i0;
#pragma unroll
                for (int bj = 0; bj < 2; ++bj) { *(f32x4*)(kp + bj * HALF) = ks[bj][0]; *(f32x4*)(kp + bj * HALF + 32) = ks[bj][1]; }
            }
        }
    }
};
struct EpiRes {
    static constexpr bool PERM = true, AFTER_DRAIN = false;
    unsigned char* ws; const float* xres; const float* lw; const float* lb; int mode, ysrc_mib, ydst_mib, stp_mib, sto_mib;
    __device__ __forceinline__ void operator()(const f32x4 (&acc)[2][2][4][2], const Unit& u, int wr, int wc, int fr, int fq) const {
        const bf16_t* yprev = (const bf16_t*)(ws + ((size_t)ysrc_mib << 20)); bf16_t* Y = (bf16_t*)(ws + ((size_t)ydst_mib << 20));
        const float* stp = (const float*)(ws + ((size_t)stp_mib << 20)); float* sto = (float*)(ws + ((size_t)sto_mib << 20));
        extern __shared__ __attribute__((aligned(16))) unsigned char lds_all[];
        PG8_LAS unsigned char* tab = (PG8_LAS unsigned char*)lds_all + EPI_TAB_OFF;
        const int c0 = u.pn * BM + wc * 32 + 8 * fq;
        f32x4 wv[2][2], bv[2][2];
#pragma unroll
        for (int bj = 0; bj < 2; ++bj)
#pragma unroll
            for (int n = 0; n < 2; ++n) { wv[bj][n] = mode ? *(const f32x4*)(lw + c0 + bj * HALF + 4 * n) : (f32x4){1.f, 1.f, 1.f, 1.f}; bv[bj][n] = mode ? *(const f32x4*)(lb + c0 + bj * HALF + 4 * n) : (f32x4){0.f, 0.f, 0.f, 0.f}; }
        PG8_LAS f32x2* T = (PG8_LAS f32x2*)tab;
#pragma unroll
        for (int ai = 0; ai < 2; ++ai)
#pragma unroll
            for (int m = 0; m < 4; ++m) {
                const int rowt = ai * HALF + wr * 64 + m * 16 + fr, row = u.pm * BM + rowt;
                float mu = 0.f, rs = 1.f; if (mode) row_stats(stp, row, mu, rs);
                float s = 0.f, q = 0.f;
#pragma unroll
                for (int bj = 0; bj < 2; ++bj) {
                    f32x4 r0, r1; const size_t off = (size_t)row * 1024 + c0 + bj * HALF;
                    if (mode) { const u32x4 yb = *(const u32x4*)(yprev + off);
                        r0 = (f32x4){__uint_as_float(yb.x << 16), __uint_as_float(yb.x & 0xffff0000u), __uint_as_float(yb.y << 16), __uint_as_float(yb.y & 0xffff0000u)};
                        r1 = (f32x4){__uint_as_float(yb.z << 16), __uint_as_float(yb.z & 0xffff0000u), __uint_as_float(yb.w << 16), __uint_as_float(yb.w & 0xffff0000u)};
                        r0 = (r0 - mu) * rs * wv[bj][0] + bv[bj][0]; r1 = (r1 - mu) * rs * wv[bj][1] + bv[bj][1];
                    } else { r0 = *(const f32x4*)(xres + off); r1 = *(const f32x4*)(xres + off + 4); }
                    const f32x4 v0 = r0 * ALPHA_F + acc[ai][bj][m][0], v1 = r1 * ALPHA_F + acc[ai][bj][m][1];
                    s += ((v0[0] + v0[1]) + (v0[2] + v0[3])) + ((v1[0] + v1[1]) + (v1[2] + v1[3]));
                    q += ((v0[0] * v0[0] + v0[1] * v0[1]) + (v0[2] * v0[2] + v0[3] * v0[3])) + ((v1[0] * v1[0] + v1[1] * v1[1]) + (v1[2] * v1[2] + v1[3] * v1[3]));
                    u32x4 w; w.x = cvt_pk_bf16(v0[0], v0[1]); w.y = cvt_pk_bf16(v0[2], v0[3]); w.z = cvt_pk_bf16(v1[0], v1[1]); w.w = cvt_pk_bf16(v1[2], v1[3]);
                    *(u32x4*)(Y + off) = w;
                }
                s += __shfl_xor(s, 16); s += __shfl_xor(s, 32); q += __shfl_xor(q, 16); q += __shfl_xor(q, 32);
                if (fq == 0) T[rowt * 4 + wc] = (f32x2){s, q};
                if (m & 1) asm volatile("" ::: "memory");
            }
        asm volatile("s_waitcnt lgkmcnt(0)" ::: "memory"); __builtin_amdgcn_s_barrier(); asm volatile("" ::: "memory");
        const int tid = threadIdx.x;
        if (tid < 256) { const f32x4 a = *(const PG8_LAS f32x4*)(tab + tid * 32), b = *(const PG8_LAS f32x4*)(tab + tid * 32 + 16);
            *(f32x2*)(sto + (size_t)(u.pm * BM + tid) * 8 + u.pn * 2) = (f32x2){(a[0] + a[2]) + (b[0] + b[2]), (a[1] + a[3]) + (b[1] + b[3])}; }
    }
};
struct EpiUp {
    static constexpr bool PERM = true, AFTER_DRAIN = false;
    unsigned char* ws; const float* st; int l;
    __device__ __forceinline__ void operator()(const f32x4 (&acc)[2][2][4][2], const Unit& u, int wr, int wc, int fr, int fq) const {
        bf16_t* H = (bf16_t*)(ws + EPI_WS_HID); const float* cs = (const float*)(ws + EPI_WS_VEC) + 4 * 3072 + l * 4096; const float* bb = cs + 2 * 4096;
        const int c0 = u.pn * BM + wc * 32 + 8 * fq;
        f32x4 csv[2][2], bbv[2][2];
#pragma unroll
        for (int bj = 0; bj < 2; ++bj)
#pragma unroll
            for (int n = 0; n < 2; ++n) { csv[bj][n] = *(const f32x4*)(cs + c0 + bj * HALF + 4 * n); bbv[bj][n] = *(const f32x4*)(bb + c0 + bj * HALF + 4 * n); }
#pragma unroll
        for (int ai = 0; ai < 2; ++ai)
#pragma unroll
            for (int m = 0; m < 4; ++m) {
                const int row = u.pm * BM + ai * HALF + wr * 64 + m * 16 + fr;
                float mu, rs; row_stats(st, row, mu, rs);
#pragma unroll
                for (int bj = 0; bj < 2; ++bj) {
                    f32x4 v0 = (acc[ai][bj][m][0] - mu * csv[bj][0]) * rs + bbv[bj][0], v1 = (acc[ai][bj][m][1] - mu * csv[bj][1]) * rs + bbv[bj][1];
#pragma unroll
                    for (int e = 0; e < 4; ++e) { const float a = fmaxf(v0[e], 0.f), b = fmaxf(v1[e], 0.f); v0[e] = a * a; v1[e] = b * b; }
                    u32x4 w; w.x = cvt_pk_bf16(v0[0], v0[1]); w.y = cvt_pk_bf16(v0[2], v0[3]); w.z = cvt_pk_bf16(v1[0], v1[1]); w.w = cvt_pk_bf16(v1[2], v1[3]);
                    *(u32x4*)(H + (size_t)row * 4096 + c0 + bj * HALF) = w;
                }
                if (m & 1) asm volatile("" ::: "memory");
            }
    }
};

template <class Epi, class Sched, bool ALIGN_EPI = false, bool SP2 = false>
__device__ __forceinline__ void gemm_phase(PG8_LAS unsigned char* lds, const Gemm g, const Sched& S, const Epi& E) {
    int tid_ = threadIdx.x; asm volatile("" : "+v"(tid_));
    const int tid = tid_, wid = __builtin_amdgcn_readfirstlane(tid >> 6), lane = tid & 63, wr = wid >> 2, wc = wid & 3, fr = lane & 15, fq = lane >> 4;
    const int K = g.K, nt = K / BK;
    unsigned voffA[2], voffB[2];
#pragma unroll
    for (int i = 0; i < 2; ++i) { int R, C; stage_rc(tid * 16 + i * 8192, R, C); const int Rb = Epi::PERM ? ((R & ~31) + perm32(R & 31)) : R;
        voffA[i] = (unsigned)(R * K + C) * 2u; voffB[i] = (unsigned)(Rb * K + C) * 2u; }
    const size_t kstep = (size_t)(BK * 2);
    const size_t hstep = (size_t)HALF * K * 2;
    const size_t tstep = 2 * hstep;
    const unsigned ldsw = (unsigned)wid * 1024u;
    const int aoff = lds_byte(wr * 64 + fr, fq * 8), boff = lds_byte(wc * 32 + fr, fq * 8);
#define PG8_SA(b, h) (((b) * 2 + (h)) * HTB)
#define PG8_SB(b, h) ((4 + (b) * 2 + (h)) * HTB)
#define PG8_STAGE(bufoff, gbase, voff) do { _Pragma("unroll") for (int _i = 0; _i < 2; ++_i) \
        __builtin_amdgcn_global_load_lds((const unsigned*)((const char*)(gbase) + (voff)[_i]), (PG8_LAS unsigned*)(lds + (bufoff) + ldsw + _i * 8192), 16, 0, 0); } while (0)
#define PG8_LDA(dst, b, h) do { _Pragma("unroll") for (int m = 0; m < 4; ++m) _Pragma("unroll") for (int k = 0; k < 2; ++k) dst[m][k] = *(const PG8_LAS bf16x8*)(lds + PG8_SA(b, h) + aoff + m * 2048 + k * 1024); } while (0)
#define PG8_LDB(dst, b, h) do { _Pragma("unroll") for (int n = 0; n < 2; ++n) _Pragma("unroll") for (int k = 0; k < 2; ++k) dst[n][k] = *(const PG8_LAS bf16x8*)(lds + PG8_SB(b, h) + boff + n * 2048 + k * 1024); } while (0)
#define PG8_MMA(ai, bj, At, Bt) do { __builtin_amdgcn_s_setprio(1); _Pragma("unroll") for (int m = 0; m < 4; ++m) _Pragma("unroll") for (int n = 0; n < 2; ++n) _Pragma("unroll") for (int k = 0; k < 2; ++k) \
        acc[ai][bj][m][n] = __builtin_amdgcn_mfma_f32_16x16x32_bf16(Bt[n][k], At[m][k], acc[ai][bj][m][n], 0, 0, 0); __builtin_amdgcn_s_setprio(0); } while (0)
#define PG8_WAIT_V(n) asm volatile("s_waitcnt vmcnt(" #n ")" ::: "memory")
#define PG8_WAIT_L(n) asm volatile("s_waitcnt lgkmcnt(" #n ")" ::: "memory")
#define PG8_BAR __builtin_amdgcn_s_barrier()
#define PG8_SCHED __builtin_amdgcn_sched_barrier(0)
    Unit cur, nxt; int ui = 0;
    if (!S.next(0, cur)) return;
    f32x4 acc[2][2][4][2];
#pragma unroll
    for (int a = 0; a < 2; ++a)
#pragma unroll
        for (int b = 0; b < 2; ++b)
#pragma unroll
            for (int m = 0; m < 4; ++m)
#pragma unroll
                for (int n = 0; n < 2; ++n) acc[a][b][m][n] = (f32x4){0.f, 0.f, 0.f, 0.f};
    bf16x8 At[4][2], B0[2][2], B1[2][2];
    const char* cA = (const char*)g.A + (size_t)cur.pm * tstep; const char* cB = (const char*)g.Bt + (size_t)cur.pn * tstep;
    S.a_ready(cur);
    if constexpr (SP2) {
        PG8_STAGE(PG8_SB(0, 0), cB, voffB); PG8_STAGE(PG8_SB(0, 1), cB + hstep, voffB); PG8_STAGE(PG8_SA(0, 0), cA, voffA); PG8_STAGE(PG8_SA(0, 1), cA + hstep, voffA);
        if (wr == 1) PG8_BAR;
        PG8_WAIT_V(2); PG8_BAR;
        PG8_STAGE(PG8_SB(1, 0), cB + kstep, voffB); PG8_STAGE(PG8_SA(1, 0), cA + kstep, voffA); PG8_STAGE(PG8_SB(1, 1), cB + hstep + kstep, voffB);
        PG8_WAIT_V(6); PG8_BAR;
    } else {
        PG8_STAGE(PG8_SB(0, 0), cB, voffB); PG8_STAGE(PG8_SA(0, 0), cA, voffA); PG8_STAGE(PG8_SB(0, 1), cB + hstep, voffB); PG8_STAGE(PG8_SA(0, 1), cA + hstep, voffA);
        if (wr == 1) PG8_BAR;
        PG8_WAIT_V(4); PG8_BAR;
        PG8_STAGE(PG8_SB(1, 0), cB + kstep, voffB); PG8_STAGE(PG8_SA(1, 0), cA + kstep, voffA); PG8_STAGE(PG8_SB(1, 1), cB + hstep + kstep, voffB);
        PG8_WAIT_V(6); PG8_BAR;
    }
    for (;;) {
        const bool has_next = S.next(ui + 1, nxt);
        const char* nA = has_next ? (const char*)g.A + (size_t)nxt.pm * tstep : cA; const char* nB = has_next ? (const char*)g.Bt + (size_t)nxt.pn * tstep : cB;
        for (int t = 0; t < nt; t += 2) {
            const bool last = (t == nt - 2);
            const char* a1 = cA + (size_t)(t + 1) * kstep;
            const char* a2 = last ? nA : cA + (size_t)(t + 2) * kstep; const char* b2 = last ? nB : cB + (size_t)(t + 2) * kstep;
            const char* a3 = a2 + kstep; const char* b3 = b2 + kstep;
            if (last && has_next) S.a_ready(nxt);
            if constexpr (SP2) {
            PG8_LDB(B0, 0, 0); PG8_LDB(B1, 0, 1); PG8_SCHED; PG8_LDA(At, 0, 0); PG8_STAGE(PG8_SA(1, 1), a1 + hstep, voffA);
            PG8_WAIT_V(8); PG8_WAIT_L(0); PG8_BAR; PG8_MMA(0, 0, At, B0); PG8_MMA(0, 1, At, B1); PG8_BAR; PG8_SCHED;
            PG8_LDA(At, 0, 1); PG8_STAGE(PG8_SB(0, 0), b2, voffB); PG8_STAGE(PG8_SB(0, 1), b2 + hstep, voffB); PG8_STAGE(PG8_SA(0, 0), a2, voffA);
            PG8_WAIT_V(8); PG8_WAIT_L(0); PG8_BAR; PG8_MMA(1, 0, At, B0); PG8_MMA(1, 1, At, B1); PG8_BAR; PG8_SCHED;
            PG8_LDB(B0, 1, 0); PG8_LDB(B1, 1, 1); PG8_SCHED; PG8_LDA(At, 1, 0); PG8_STAGE(PG8_SA(0, 1), a2 + hstep, voffA);
            PG8_WAIT_V(8); PG8_WAIT_L(0); PG8_BAR; PG8_MMA(0, 0, At, B0); PG8_MMA(0, 1, At, B1); PG8_BAR; PG8_SCHED;
            PG8_LDA(At, 1, 1); PG8_STAGE(PG8_SB(1, 0), b3, voffB); PG8_STAGE(PG8_SB(1, 1), b3 + hstep, voffB); PG8_STAGE(PG8_SA(1, 0), a3, voffA);
            PG8_WAIT_V(8); PG8_WAIT_L(0); PG8_BAR; PG8_MMA(1, 0, At, B0); PG8_MMA(1, 1, At, B1); PG8_BAR; PG8_SCHED;
            } else {
            PG8_LDB(B0, 0, 0); PG8_SCHED; PG8_LDA(At, 0, 0); PG8_STAGE(PG8_SA(1, 1), a1 + hstep, voffA);
            PG8_WAIT_L(8); PG8_BAR; PG8_WAIT_L(0); PG8_MMA(0, 0, At, B0); PG8_BAR; PG8_SCHED;
            PG8_LDB(B1, 0, 1); PG8_STAGE(PG8_SB(0, 0), b2, voffB);
            PG8_BAR; PG8_WAIT_L(0); PG8_MMA(0, 1, At, B1); PG8_BAR;
            PG8_LDA(At, 0, 1); PG8_STAGE(PG8_SA(0, 0), a2, voffA);
            PG8_BAR; PG8_WAIT_L(0); PG8_MMA(1, 0, At, B0); PG8_BAR; PG8_SCHED;
            PG8_STAGE(PG8_SB(0, 1), b2 + hstep, voffB);
            PG8_WAIT_V(6); PG8_BAR; PG8_MMA(1, 1, At, B1); PG8_BAR;
            PG8_LDB(B0, 1, 0); PG8_SCHED; PG8_LDA(At, 1, 0); PG8_STAGE(PG8_SA(0, 1), a2 + hstep, voffA);
            PG8_WAIT_L(8); PG8_BAR; PG8_WAIT_L(0); PG8_MMA(0, 0, At, B0); PG8_BAR; PG8_SCHED;
            PG8_LDB(B1, 1, 1); PG8_STAGE(PG8_SB(1, 0), b3, voffB);
            PG8_BAR; PG8_WAIT_L(0); PG8_MMA(0, 1, At, B1); PG8_BAR;
            PG8_LDA(At, 1, 1); PG8_STAGE(PG8_SA(1, 0), a3, voffA);
            PG8_BAR; PG8_WAIT_L(0); PG8_MMA(1, 0, At, B0); PG8_BAR; PG8_SCHED;
            PG8_STAGE(PG8_SB(1, 1), b3 + hstep, voffB);
            PG8_WAIT_V(6); PG8_BAR; PG8_MMA(1, 1, At, B1); PG8_BAR;
            }
        }
        if constexpr (ALIGN_EPI) { if (wr == 0) PG8_BAR; }
        if constexpr (!Epi::AFTER_DRAIN) { E(acc, cur, wr, wc, fr, fq); S.done(cur); }
        if (!has_next) break;
#pragma unroll
        for (int a = 0; a < 2; ++a)
#pragma unroll
            for (int b = 0; b < 2; ++b)
#pragma unroll
                for (int m = 0; m < 4; ++m)
#pragma unroll
                    for (int n = 0; n < 2; ++n) acc[a][b][m][n] = (f32x4){0.f, 0.f, 0.f, 0.f};
        cur = nxt; cA = nA; cB = nB; ++ui;
        if constexpr (ALIGN_EPI) { if (wr == 1) PG8_BAR; }
    }
    PG8_WAIT_V(0);
    if constexpr (!ALIGN_EPI) { if (wr == 0) PG8_BAR; }
    PG8_BAR;
    if constexpr (Epi::AFTER_DRAIN) { E.fused(acc, cur, wr, wc, fr, fq, lds, wid, lane); S.done(cur); }
#undef PG8_SA
#undef PG8_SB
#undef PG8_STAGE
#undef PG8_LDA
#undef PG8_LDB
#undef PG8_MMA
#undef PG8_WAIT_V
#undef PG8_WAIT_L
#undef PG8_BAR
#undef PG8_SCHED
}
}

constexpr int NWAVES = 8;
constexpr int BATCH = 16, SEQ = 4096, DM = 1024, FF = 4096, NIN = 3072, DEPTH = 2;
constexpr int M = BATCH * SEQ;
#ifndef MK_ONE_LAUNCH
#define MK_ONE_LAUNCH 1
#endif
constexpr int N_PHASES = 12;
constexpr size_t MiB = 1u << 20;
constexpr size_t WS_CTL = 0, CTL_ZERO_BYTES = 1 * MiB;
constexpr size_t WS_COS = 1 * MiB, WS_SIN = WS_COS + 512 * 1024;
constexpr size_t WS_KPART = 2 * MiB;
constexpr size_t WS_VEC = 2 * MiB + 512 * 1024;
constexpr size_t WS_PART = 3 * MiB;
constexpr size_t WS_ST = 6 * MiB;
constexpr size_t WS_W = 16 * MiB;
constexpr size_t WS_XB = 64 * MiB;
constexpr size_t WS_Y1 = 192 * MiB;
constexpr size_t WS_PROJ = 320 * MiB;
constexpr size_t WS_MIXED = 704 * MiB;
constexpr size_t WS_HID = 320 * MiB;
constexpr size_t WS_END = 832 * MiB;
constexpr int CW_TMO = 0, CW_CODE = 1;
constexpr int CW_BAR = 4096;
constexpr int CW_Q = 16384;
constexpr int VEC_CSIN = 0, VEC_BBIN = 2 * 3072, VEC_CSUP = 4 * 3072, VEC_BBUP = 4 * 3072 + 2 * 4096;
constexpr int PART_IN_CS = 0, PART_IN_BB = 16 * 3072, PART_UP = 32 * 3072;
constexpr int RING_OFF = 0, RING_BYTES = 131072;
constexpr int TAB_OFF = RING_BYTES;
constexpr int LDSCTL_OFF = RING_BYTES + 8192, MISC_OFF = LDSCTL_OFF + 320;
constexpr int LDS_BYTES = 147456;
static_assert(MISC_OFF + 128 <= LDS_BYTES, "LDS map");
static_assert(pg8::EPI_TAB_OFF == TAB_OFF && pg8::EPI_WS_COS == WS_COS && pg8::EPI_WS_KPART == WS_KPART && pg8::EPI_WS_VEC == WS_VEC && pg8::EPI_WS_PROJ == WS_PROJ && pg8::EPI_WS_HID == WS_HID && WS_SIN == WS_COS + 4096 * 32 * 4 && VEC_BBIN == VEC_CSIN + 2 * 3072 && VEC_CSUP == 4 * 3072 && VEC_BBUP == VEC_CSUP + 2 * 4096, "epilogue view of the d_ws map");
#define GAS __attribute__((address_space(1)))
#define LAS __attribute__((address_space(3)))
typedef unsigned short bf16;
typedef unsigned v4u __attribute__((ext_vector_type(4)));
typedef float f32x4 __attribute__((ext_vector_type(4)));
typedef short bf16x8 __attribute__((ext_vector_type(8)));
typedef GAS unsigned gu32;
typedef GAS unsigned long long gu64;
#define RLX_AGENT __ATOMIC_RELAXED, __HIP_MEMORY_SCOPE_AGENT
#define LDS_WAIT() asm volatile("s_waitcnt lgkmcnt(0)" ::: "memory")
#define VM_WAIT() asm volatile("s_waitcnt vmcnt(0)" ::: "memory")
__device__ __forceinline__ unsigned long long rt() { return __builtin_amdgcn_s_memrealtime(); }
__device__ __forceinline__ unsigned f2bf(float f) { unsigned u = __builtin_bit_cast(unsigned, f); return (u + 0x7fffu + ((u >> 16) & 1u)) >> 16; }
__device__ __forceinline__ unsigned pk2(float lo, float hi) { return f2bf(lo) | (f2bf(hi) << 16); }

#define XB_TMO      128
#define XB_XCNT(j)  (256  + 64 * (j))
#define XB_XSUB(j)  (1280 + 64 * (j))
#define XB_XGEN(j)  (2304 + 64 * (j))
#define XB_TOP      3328
#define XB_TOPGEN   3392
#define XCD_BAR_WORDS 3456
#define XB_SPIN_CAP (1u << 18)

__device__ __forceinline__ unsigned xb_ld(unsigned* p)              { return __hip_atomic_load(p, __ATOMIC_RELAXED, __HIP_MEMORY_SCOPE_AGENT); }
__device__ __forceinline__ unsigned xb_add(unsigned* p, unsigned v) { return __hip_atomic_fetch_add(p, v, __ATOMIC_RELAXED, __HIP_MEMORY_SCOPE_AGENT); }
__device__ __forceinline__ unsigned xb_xcc_id() { return (unsigned)__builtin_amdgcn_s_getreg((3 << 11) | 20) & 0xFu; }
#define XB_SPIN(cond, bar) do { unsigned _sp = 0; while (cond) { __builtin_amdgcn_s_sleep(1); \
    if ((++_sp & 255u) == 0u) { if (xb_ld(&(bar)[XB_TMO])) break; if (_sp > XB_SPIN_CAP) { atomicAdd(&(bar)[XB_TMO], 1u); break; } } } } while (0)

struct XcdBarrier {
    unsigned* bar; unsigned x;
    volatile LAS unsigned* st;
};

__device__ __forceinline__ XcdBarrier xcd_barrier_post(unsigned* bar, volatile LAS unsigned* st) {
    XcdBarrier b; b.bar = bar; b.x = xb_xcc_id(); b.st = st;
    if (threadIdx.x == 0) (void)xb_add(&bar[XB_XCNT(b.x)], 1u);
    return b;
}
__device__ __forceinline__ void xcd_barrier_complete(unsigned* bar, unsigned x, unsigned& nloc, unsigned& nx) {
    const unsigned G = gridDim.x * gridDim.y * gridDim.z;
    unsigned sum, cnt, mine, sp = 0u;
    for (;;) {
        sum = 0u; cnt = 0u; mine = 0u;
#pragma unroll
        for (unsigned j = 0; j < 16; ++j) { const unsigned c = xb_ld(&bar[XB_XCNT(j)]); sum += c; cnt += (c > 0u) ? 1u : 0u; mine = (j == x) ? c : mine; }
        if (sum == G) break;
        __builtin_amdgcn_s_sleep(1);
        if ((++sp & 255u) == 0u) { if (xb_ld(&bar[XB_TMO])) break; if (sp > XB_SPIN_CAP) { atomicAdd(&bar[XB_TMO], 1u); break; } }
    }
    nloc = mine > 0u ? mine : 1u; nx = cnt > 0u ? cnt : 1u;
}

__device__ __forceinline__ void xcd_barrier(const XcdBarrier& b) {
    asm volatile("s_waitcnt vmcnt(0)" ::: "memory");
    __syncthreads();
    if (threadIdx.x == 0) {
        unsigned* bar = b.bar;
        __builtin_amdgcn_s_waitcnt(0);
        unsigned nloc = b.st[0], nx = b.st[1];
        if (nloc == 0u) { xcd_barrier_complete(bar, b.x, nloc, nx); b.st[0] = nloc; b.st[1] = nx; }
        const unsigned old = xb_add(&bar[XB_XSUB(b.x)], 1u);
        const unsigned gen = old / nloc;
        if (old + 1u == (gen + 1u) * nloc) {
            __builtin_amdgcn_fence(__ATOMIC_RELEASE, "agent");
            asm volatile("s_waitcnt vmcnt(0)" ::: "memory");
            const unsigned og = xb_add(&bar[XB_TOP], 1u);
            const unsigned tg = og / nx;
            if (og + 1u == (tg + 1u) * nx) xb_add(&bar[XB_TOPGEN], 1u);
            else XB_SPIN(xb_ld(&bar[XB_TOPGEN]) == tg, bar);
            __builtin_amdgcn_fence(__ATOMIC_ACQUIRE, "agent");
            xb_add(&bar[XB_XGEN(b.x)], 1u);
            asm volatile("s_waitcnt vmcnt(0)" ::: "memory");
        } else {
            XB_SPIN(xb_ld(&bar[XB_XGEN(b.x)]) == gen, bar);
            __builtin_amdgcn_fence(__ATOMIC_ACQUIRE, "agent");
            asm volatile("s_waitcnt vmcnt(0)" ::: "memory");
        }
    }
    __syncthreads();
}

struct Frame {
    LAS unsigned char* lds;
    volatile LAS unsigned* MISC;
    gu32* ctl;
    int tid, lane, wave;
    int vcu, G;
    unsigned char* ws;
};
__device__ __forceinline__ float bf_round(float f) { return __uint_as_float(f2bf(f) << 16); }

__device__ __forceinline__ void p0_transpose_item(const float* W, int K, int N, bf16* WT, bool swap45, const float* lnw, const float* lnb, float* csp, float* bbp, LAS float* scr, int item, int lane) {
    const int nblk = N / 32, kb = item / nblk, nb = item % nblk, k0 = 64 * kb, n0 = 32 * nb;
    float cs = 0.f, bs = 0.f;
#pragma unroll 8
    for (int i = 0; i < 32; ++i) { const int kk = 2 * i + (lane >> 5); const float w = W[(size_t)(k0 + kk) * N + n0 + (lane & 31)];
        const float r = bf_round(lnw ? w * lnw[k0 + kk] : w); scr[kk * 33 + (lane & 31)] = r; cs += r; if (lnb) bs += lnb[k0 + kk] * w; }
    if (csp) { cs += __shfl_xor(cs, 32); bs += __shfl_xor(bs, 32); if (lane < 32) { csp[(size_t)kb * N + n0 + lane] = cs; bbp[(size_t)kb * N + n0 + lane] = bs; } }
    LDS_WAIT(); asm volatile("" ::: "memory");
    const int c = lane & 7;
#pragma unroll
    for (int j = 0; j < 4; ++j) { const int n = (lane >> 3) + 8 * j; const LAS float* s = scr + (8 * c) * 33 + n;
        v4u o; o.x = pk2(s[0 * 33], s[1 * 33]); o.y = pk2(s[2 * 33], s[3 * 33]); o.z = pk2(s[4 * 33], s[5 * 33]); o.w = pk2(s[6 * 33], s[7 * 33]);
        int orow = n0 + n; if (swap45) orow = (orow & ~48) | ((orow & 16) << 1) | ((orow & 32) >> 1);
        *(GAS v4u*)(WT + (size_t)orow * K + k0 + 8 * c) = o; }
    LDS_WAIT(); asm volatile("" ::: "memory");
}
__device__ __forceinline__ bf16* w_in_t(Frame& F, int l) { return (bf16*)(F.ws + WS_W + (size_t)l * 24 * MiB); }
__device__ __forceinline__ bf16* w_out_t(Frame& F, int l) { return (bf16*)(F.ws + WS_W + (size_t)l * 24 * MiB + 6 * MiB); }
__device__ __forceinline__ bf16* w_up_t(Frame& F, int l) { return (bf16*)(F.ws + WS_W + (size_t)l * 24 * MiB + 8 * MiB); }
__device__ __forceinline__ bf16* w_down_t(Frame& F, int l) { return (bf16*)(F.ws + WS_W + (size_t)l * 24 * MiB + 16 * MiB); }
__device__ __forceinline__ float* st_buf(Frame& F, int l, int which) { return (float*)(F.ws + WS_ST + (size_t)(2 * l + which) * 2 * MiB); }

__device__ __forceinline__ void p0_prologue(Frame& F, const float* x, const float* w_in, const float* w_out, const float* ln1w, const float* ln1b, const float* w_up, const float* w_down, const float* ln2w, const float* ln2b) {
    LAS float* scr = (LAS float*)(F.lds + RING_OFF + F.wave * 16384);
    const int gw = F.vcu * NWAVES + F.wave, NGW = F.G * NWAVES;
    constexpr int I_IN = (DM / 64) * (NIN / 32), I_OUT = (DM / 64) * (DM / 32), I_UP = (DM / 64) * (FF / 32), I_DN = (FF / 64) * (DM / 32);
    constexpr int PER_L = I_IN + I_OUT + I_UP + I_DN;
    float* part = (float*)(F.ws + WS_PART);
    for (int it = gw; it < DEPTH * PER_L; it += NGW) {
        const int l = it / PER_L; int r = it % PER_L;
        if (r < I_IN) { const bool fold = l > 0;
            p0_transpose_item(w_in + (size_t)l * DM * NIN, DM, NIN, w_in_t(F, l), true, fold ? ln2w + (l - 1) * DM : nullptr, fold ? ln2b + (l - 1) * DM : nullptr,
                              fold ? part + PART_IN_CS : nullptr, fold ? part + PART_IN_BB : nullptr, scr, r, F.lane); continue; } r -= I_IN;
        if (r < I_OUT) { p0_transpose_item(w_out + (size_t)l * DM * DM, DM, DM, w_out_t(F, l), false, nullptr, nullptr, nullptr, nullptr, scr, r, F.lane); continue; } r -= I_OUT;
        if (r < I_UP) { p0_transpose_item(w_up + (size_t)l * DM * FF, DM, FF, w_up_t(F, l), false, ln1w + l * DM, ln1b + l * DM,
                              part + PART_UP + (size_t)l * 32 * FF, part + PART_UP + (size_t)l * 32 * FF + 16 * FF, scr, r, F.lane); continue; } r -= I_UP;
        p0_transpose_item(w_down + (size_t)l * FF * DM, FF, DM, w_down_t(F, l), false, nullptr, nullptr, nullptr, nullptr, scr, r, F.lane);
    }
    bf16* XB = (bf16*)(F.ws + WS_XB);
    for (int m = gw; m < M; m += NGW) {
        const GAS f32x4* xr = (const GAS f32x4*)(x + (size_t)m * DM) + F.lane; GAS unsigned long long* o8 = (GAS unsigned long long*)(XB + (size_t)m * DM) + F.lane;
        f32x4 v[4];
#pragma unroll
        for (int j = 0; j < 4; ++j) v[j] = xr[64 * j];
#pragma unroll
        for (int j = 0; j < 4; ++j) o8[64 * j] = (unsigned long long)pk2(v[j].x, v[j].y) | ((unsigned long long)pk2(v[j].z, v[j].w) << 32);
    }
    float* cosT = (float*)(F.ws + WS_COS); float* sinT = (float*)(F.ws + WS_SIN);
    for (int idx = F.vcu * (NWAVES * 64) + F.tid; idx < SEQ * 32; idx += F.G * NWAVES * 64) {
        const int pos = idx >> 5, i = idx & 31;
        const float inv = (float)exp2(-(double)i * (13.287712379549449 / 32.0));
        const float ang = (float)pos * inv;
        const double rev = (double)ang * 0.15915494309189535; const float fr = (float)(rev - floor(rev));
        cosT[idx] = __builtin_amdgcn_cosf(fr); sinT[idx] = __builtin_amdgcn_sinf(fr);
    }
}
__device__ __forceinline__ void finalize_vecs(Frame& F) {
    const float* part = (const float*)(F.ws + WS_PART); float* vec = (float*)(F.ws + WS_VEC);
    for (int idx = F.vcu * (NWAVES * 64) + F.tid; idx < NIN + 2 * FF; idx += F.G * NWAVES * 64) {
        float cs = 0.f, bs = 0.f;
        if (idx < NIN) {
#pragma unroll
            for (int kb = 0; kb < 16; ++kb) { cs += part[PART_IN_CS + kb * NIN + idx]; bs += part[PART_IN_BB + kb * NIN + idx]; }
            const int j = (idx & ~48) | ((idx & 16) << 1) | ((idx & 32) >> 1);
            vec[VEC_CSIN + NIN + j] = cs; vec[VEC_BBIN + NIN + j] = bs;
        } else { const int l = (idx - NIN) / FF, n = (idx - NIN) % FF; const float* p = part + PART_UP + (size_t)l * 32 * FF;
#pragma unroll
            for (int kb = 0; kb < 16; ++kb) { cs += p[kb * FF + n]; bs += p[16 * FF + kb * FF + n]; }
            vec[VEC_CSUP + l * FF + n] = cs; vec[VEC_BBUP + l * FF + n] = bs; }
    }
}
__device__ __forceinline__ void final_ln(Frame& F, float* out, const bf16* Y, const float* st, const float* w, const float* b) {
    const int gw = F.vcu * NWAVES + F.wave, NGW = F.G * NWAVES;
    f32x4 wv[2][2], bv[2][2];
#pragma unroll
    for (int j = 0; j < 2; ++j)
#pragma unroll
        for (int h = 0; h < 2; ++h) { wv[j][h] = *(const f32x4*)(w + 512 * j + 8 * F.lane + 4 * h); bv[j][h] = *(const f32x4*)(b + 512 * j + 8 * F.lane + 4 * h); }
    for (int m = gw; m < M; m += NGW) {
        float mu, rs; pg8::row_stats(st, m, mu, rs);
#pragma unroll
        for (int j = 0; j < 2; ++j) { const v4u yb = *(const GAS v4u*)(Y + (size_t)m * DM + 512 * j + 8 * F.lane);
            f32x4 r0 = (f32x4){__uint_as_float(yb.x << 16), __uint_as_float(yb.x & 0xffff0000u), __uint_as_float(yb.y << 16), __uint_as_float(yb.y & 0xffff0000u)};
            f32x4 r1 = (f32x4){__uint_as_float(yb.z << 16), __uint_as_float(yb.z & 0xffff0000u), __uint_as_float(yb.w << 16), __uint_as_float(yb.w & 0xffff0000u)};
            r0 = (r0 - mu) * rs * wv[j][0] + bv[j][0]; r1 = (r1 - mu) * rs * wv[j][1] + bv[j][1];
            GAS f32x4* o = (GAS f32x4*)(out + (size_t)m * DM + 512 * j + 8 * F.lane); o[0] = r0; o[1] = r1; }
    }
}
typedef float f32x16 __attribute__((ext_vector_type(16)));
typedef short s16x4 __attribute__((ext_vector_type(4)));
typedef unsigned u32x2m __attribute__((ext_vector_type(2)));
#define MFMA32(a, b, c) __builtin_amdgcn_mfma_f32_32x32x16_bf16((a), (b), (c), 0, 0, 0)
#define WG_BAR() asm volatile("s_waitcnt lgkmcnt(0)\n\ts_barrier" ::: "memory")
constexpr int COL_AQ = 0, COL_AK = 256, COL_AV = 384, COL_BQ = 512, COL_BK = 768, COL_BV = 1024, COL_CQ = 1280, COL_CK = 1536, COL_CV = 1792, COL_DQ = 2048, COL_DK = 2304, COL_DV = 2560, COL_DG = 2816;
__device__ __forceinline__ int kimg(int row, int ch) { return row * 128 + ((ch ^ ((row >> 1) & 7)) << 4); }
__device__ __forceinline__ int vimg(int row, int ch) { return row * 128 + ((ch ^ (((row >> 1) & 1) << 2)) << 4); }
__device__ __forceinline__ int kperm(int i) { return 16 * ((i >> 2) & 1) + (i & 3) + 4 * (i >> 3); }
__device__ __forceinline__ bf16x8 lds_row8(const LAS unsigned char* p) { return *(const LAS bf16x8*)p; }
__device__ __forceinline__ bf16x8 lds_tr8(const LAS unsigned char* p) {
    typedef short v4s __attribute__((ext_vector_type(4)));
    const v4s lo = __builtin_amdgcn_ds_read_tr16_b64_v4i16((LAS v4s*)p), hi = __builtin_amdgcn_ds_read_tr16_b64_v4i16((LAS v4s*)(p + 512));
    return (bf16x8){lo[0], lo[1], lo[2], lo[3], hi[0], hi[1], hi[2], hi[3]};
}
__device__ __forceinline__ int tr_lane_off(int lane, int rbase, int cb) { const int q = (lane & 15) >> 2, pp = lane & 3, blk = (lane >> 4) & 1; return vimg(rbase + q, 4 * cb + 2 * blk + (pp >> 1)) + 8 * (pp & 1); }
typedef float f32x2_t __attribute__((ext_vector_type(2))); typedef __bf16 bf16x2_t __attribute__((ext_vector_type(2)));
__device__ __forceinline__ unsigned pk_bf16(float lo, float hi) { f32x2_t v = {lo, hi}; bf16x2_t b = __builtin_convertvector(v, bf16x2_t); return __builtin_bit_cast(unsigned, b); }
__device__ __forceinline__ float bf_lo(unsigned u) { return __uint_as_float(u << 16); }
__device__ __forceinline__ float bf_hi(unsigned u) { return __uint_as_float(u & 0xffff0000u); }
__device__ __forceinline__ float xsum32(float v) { auto rr = __builtin_amdgcn_permlane32_swap(__float_as_uint(v), __float_as_uint(v), false, false); return __uint_as_float(rr[0]) + __uint_as_float(rr[1]); }

__device__ __forceinline__ void ret_chain(Frame& F, int b, int h) {
    const bf16* P = (const bf16*)(F.ws + WS_PROJ); bf16* MX = (bf16*)(F.ws + WS_MIXED);
    LAS unsigned char* L = F.lds + RING_OFF;
    constexpr int T_Q = 0, T_K = 16384, T_KW = 32768, T_V = 49152, T_S = 65536;
    const int tid = F.tid, lane = F.lane, w = F.wave, iq = lane & 31, hi = lane >> 5;
    const float gam = 1.0f - 1.0f / (float)(32 << h); const float lg2 = __builtin_amdgcn_logf(gam);
    for (int i = tid; i < 8192 / 16; i += NWAVES * 64) *(LAS v4u*)(L + T_S + i * 16) = (v4u){0u, 0u, 0u, 0u};
    const size_t rowbase = (size_t)b * SEQ;
    v4u rq[2], rk[2], rv[2];
#define RET_LOAD(n) do { _Pragma("unroll") for (int k = 0; k < 2; ++k) { const int p = tid + 512 * k, row = p >> 3, ch = p & 7; const bf16* src = P + (rowbase + (size_t)(n) * 128 + row) * NIN + 64 * h + 8 * ch; \
        rq[k] = *(const GAS v4u*)(src + COL_DQ); rk[k] = *(const GAS v4u*)(src + COL_DK); rv[k] = *(const GAS v4u*)(src + COL_DV); } } while (0)
    RET_LOAD(0);
    f32x16 state;
#pragma unroll
    for (int r = 0; r < 16; ++r) state[r] = 0.f;
    const float g128 = __builtin_amdgcn_exp2f(128.f * lg2);
    float cr[16];
#pragma unroll
    for (int r = 0; r < 16; ++r) cr[r] = __builtin_amdgcn_exp2f(-(float)r * lg2);
    int cur = 0;
    for (int n = 0; n < SEQ / 128; ++n) {
#pragma unroll
        for (int k = 0; k < 2; ++k) { const int p = tid + 512 * k, row = p >> 3, ch = p & 7;
            *(LAS v4u*)(L + T_Q + kimg(row, ch)) = rq[k]; *(LAS v4u*)(L + T_K + kimg(row, ch)) = rk[k]; *(LAS v4u*)(L + T_V + vimg(row, ch)) = rv[k];
            const float f = __builtin_amdgcn_exp2f((float)(127 - row) * lg2); v4u kw;
            kw.x = pk_bf16(bf_lo(rk[k].x) * f, bf_hi(rk[k].x) * f); kw.y = pk_bf16(bf_lo(rk[k].y) * f, bf_hi(rk[k].y) * f); kw.z = pk_bf16(bf_lo(rk[k].z) * f, bf_hi(rk[k].z) * f); kw.w = pk_bf16(bf_lo(rk[k].w) * f, bf_hi(rk[k].w) * f);
            *(LAS v4u*)(L + T_KW + vimg(row, ch)) = kw; }
        if (n + 1 < SEQ / 128) RET_LOAD(n + 1);
        WG_BAR();
        if (w < 4) {
            const int rb = w;
            bf16x8 qf[4];
#pragma unroll
            for (int d0 = 0; d0 < 4; ++d0) qf[d0] = lds_row8(L + T_Q + kimg(32 * rb + iq, 2 * d0 + hi));
            f32x16 cx[2], oa[2];
#pragma unroll
            for (int eb = 0; eb < 2; ++eb) {
#pragma unroll
                for (int r = 0; r < 16; ++r) { cx[eb][r] = 0.f; oa[eb][r] = 0.f; }
#pragma unroll
                for (int d0 = 0; d0 < 4; ++d0) { const bf16x8 sf = lds_tr8(L + T_S + cur * 8192 + tr_lane_off(lane, 16 * d0 + 8 * hi, eb)); cx[eb] = MFMA32(sf, qf[d0], cx[eb]); }
            }
            for (int kb = 0; kb <= rb; ++kb) {
                f32x16 st;
#pragma unroll
                for (int r = 0; r < 16; ++r) st[r] = 0.f;
#pragma unroll
                for (int d0 = 0; d0 < 4; ++d0) { const bf16x8 kf = lds_row8(L + T_K + kimg(32 * kb + kperm(iq), 2 * d0 + hi)); st = MFMA32(kf, qf[d0], st); }
                const float fl = __builtin_amdgcn_exp2f((float)(32 * (rb - kb) + iq - 16 * hi) * lg2);
                const int lim = (kb == rb) ? (iq - 16 * hi) : 64;
                unsigned pw[8];
#pragma unroll
                for (int r = 0; r < 16; r += 2) { const float a = (r <= lim) ? st[r] * cr[r] * fl : 0.f, c = (r + 1 <= lim) ? st[r + 1] * cr[r + 1] * fl : 0.f; pw[r >> 1] = pk_bf16(a, c); }
#pragma unroll
                for (int s = 0; s < 2; ++s) { const bf16x8 pf = __builtin_bit_cast(bf16x8, (v4u){pw[4 * s], pw[4 * s + 1], pw[4 * s + 2], pw[4 * s + 3]});
#pragma unroll
                    for (int eb = 0; eb < 2; ++eb) { const bf16x8 vf = lds_tr8(L + T_V + tr_lane_off(lane, 32 * kb + 16 * hi + 8 * s, eb)); oa[eb] = MFMA32(vf, pf, oa[eb]); } }
            }
            const float cw = __builtin_amdgcn_exp2f((float)(32 * rb + iq + 1) * lg2);
            float s1 = 0.f;
#pragma unroll
            for (int eb = 0; eb < 2; ++eb)
#pragma unroll
                for (int r = 0; r < 16; ++r) { oa[eb][r] += cw * cx[eb][r]; s1 += oa[eb][r]; }
            s1 = xsum32(s1); const float mean = s1 * (1.f / 64.f);
            float s2 = 0.f;
#pragma unroll
            for (int eb = 0; eb < 2; ++eb)
#pragma unroll
                for (int r = 0; r < 16; ++r) { const float d = oa[eb][r] - mean; oa[eb][r] = d; s2 += d * d; }
            s2 = xsum32(s2); const float rstd = 1.0f / sqrtf(s2 * (1.f / 64.f) + 1e-5f);
            const size_t grow = rowbase + (size_t)n * 128 + 32 * rb + iq;
            const bf16* gp = P + grow * NIN + COL_DG + 64 * h; bf16* op = MX + grow * DM + 768 + 64 * h;
#pragma unroll
            for (int eb = 0; eb < 2; ++eb)
#pragma unroll
                for (int g4 = 0; g4 < 4; ++g4) { const int e0 = 32 * eb + 8 * g4 + 4 * hi; const u32x2m gg = *(const GAS u32x2m*)(gp + e0);
                    const float g0 = bf_lo(gg.x), g1 = bf_hi(gg.x), g2 = bf_lo(gg.y), g3 = bf_hi(gg.y);
                    const float y0 = oa[eb][4 * g4 + 0] * rstd * (g0 / (1.f + __expf(-g0))), y1 = oa[eb][4 * g4 + 1] * rstd * (g1 / (1.f + __expf(-g1)));
                    const float y2 = oa[eb][4 * g4 + 2] * rstd * (g2 / (1.f + __expf(-g2))), y3 = oa[eb][4 * g4 + 3] * rstd * (g3 / (1.f + __expf(-g3)));
                    u32x2m o; o.x = pk_bf16(y0, y1); o.y = pk_bf16(y2, y3); *(GAS u32x2m*)(op + e0) = o; }
        } else {
            const int x = w - 4, db = x >> 1, eb = x & 1;
            f32x16 kv;
#pragma unroll
            for (int r = 0; r < 16; ++r) kv[r] = 0.f;
#pragma unroll
            for (int s = 0; s < 8; ++s) { const bf16x8 af = lds_tr8(L + T_KW + tr_lane_off(lane, 16 * s + 8 * hi, db)), bfr = lds_tr8(L + T_V + tr_lane_off(lane, 16 * s + 8 * hi, eb)); kv = MFMA32(af, bfr, kv); }
            const int nxt = cur ^ 1; const int e = iq + 32 * eb;
#pragma unroll
            for (int r = 0; r < 16; ++r) { state[r] = state[r] * g128 + kv[r]; const int d = (r & 3) + 8 * (r >> 2) + 4 * hi + 32 * db;
                *(LAS unsigned short*)(L + T_S + nxt * 8192 + vimg(d, e >> 3) + (e & 7) * 2) = (unsigned short)(pk_bf16(state[r], 0.f) & 0xffffu); }
        }
        WG_BAR();
        cur ^= 1;
    }
#undef RET_LOAD
}


template <int MODE>
__device__ __forceinline__ void attn_unit(Frame& F, int l, const float* sinks, int b, int h, int qb) {
    const bf16* P = (const bf16*)(F.ws + WS_PROJ); bf16* MX = (bf16*)(F.ws + WS_MIXED);
    LAS unsigned char* L = F.lds + RING_OFF;
    constexpr int KOFF = 0, VOFF = 16384, FLG = 32768, KMOFF = 36864;
    const int tid = F.tid, lane = F.lane, w = F.wave, iq = lane & 31, hi = lane >> 5;
    const int qcol = MODE == 0 ? COL_AQ + 64 * h : (MODE == 1 ? COL_BQ + 64 * h : COL_CQ + 64 * h);
    const int kcol = MODE == 0 ? COL_AK + 64 * (h >> 1) : (MODE == 1 ? COL_BK + 64 * h : COL_CK + 64 * h);
    const int vcol = MODE == 0 ? COL_AV + 64 * (h >> 1) : (MODE == 1 ? COL_BV + 64 * h : COL_CV + 64 * h);
    const int ocol = 256 * MODE + 64 * h;
    const size_t rowbase = (size_t)b * SEQ;
    const int q0 = 256 * qb, qw0 = q0 + 32 * w, query = qw0 + iq;
    const int kt_lo = MODE == 0 ? (qb > 0 ? 4 * qb - 2 : 0) : 0, kt_hi = 4 * qb + 4, nt = kt_hi - kt_lo;
    const int srow = tid >> 3, sch = tid & 7;
    const bf16* kbase = P + (rowbase + srow) * NIN + kcol + 8 * sch; const bf16* vbase = P + (rowbase + srow) * NIN + vcol + 8 * sch;
    v4u rk, rv;
#define ATT_KT(it) (MODE == 2 ? kt_hi - 1 - (it) : kt_lo + (it))
#define ATT_LOAD(it) do { const size_t o_ = (size_t)ATT_KT(it) * 64 * NIN; rk = *(const GAS v4u*)(kbase + o_); rv = *(const GAS v4u*)(vbase + o_); } while (0)
#define ATT_WRITE(buf) do { *(LAS v4u*)(L + KOFF + (buf) * 8192 + kimg(srow, sch)) = rk; *(LAS v4u*)(L + VOFF + (buf) * 8192 + vimg(srow, sch)) = rv; } while (0)
    ATT_LOAD(0);
    bf16x8 qf[4];
#pragma unroll
    for (int d0 = 0; d0 < 4; ++d0) qf[d0] = *(const GAS bf16x8*)(P + (rowbase + query) * NIN + qcol + 16 * d0 + 8 * hi);
    unsigned selmask = 0u;
    if (MODE == 1) {
        if (qb <= 3) selmask = (1u << qb) - 1u;
        else {
            const float* kp = (const float*)(F.ws + WS_KPART);
            for (int idx = tid; idx < qb * 64; idx += NWAVES * 64) { const int j = idx >> 6, d = idx & 63; const float* p0_ = kp + (size_t)((b * 16 + j) * 2) * 256 + 64 * h + d;
                *(LAS float*)(L + KMOFF + idx * 4) = p0_[0] + p0_[256]; }
            WG_BAR();
            float qv[32];
#pragma unroll
            for (int d0 = 0; d0 < 4; ++d0)
#pragma unroll
                for (int e = 0; e < 4; ++e) { const unsigned u = __builtin_bit_cast(v4u, qf[d0])[e]; qv[8 * d0 + 2 * e] = bf_lo(u); qv[8 * d0 + 2 * e + 1] = bf_hi(u); }
            float v1 = -INFINITY, v2 = -INFINITY, v3 = -INFINITY; int i1 = 0, i2 = 0, i3 = 0;
            for (int j = 0; j < qb; ++j) {
                float g = 0.f;
#pragma unroll
                for (int d0 = 0; d0 < 4; ++d0) { const f32x4 a = *(const LAS f32x4*)(L + KMOFF + (j * 64 + 16 * d0 + 8 * hi) * 4), c = *(const LAS f32x4*)(L + KMOFF + (j * 64 + 16 * d0 + 8 * hi + 4) * 4);
                    g += qv[8 * d0] * a[0] + qv[8 * d0 + 1] * a[1] + qv[8 * d0 + 2] * a[2] + qv[8 * d0 + 3] * a[3] + qv[8 * d0 + 4] * c[0] + qv[8 * d0 + 5] * c[1] + qv[8 * d0 + 6] * c[2] + qv[8 * d0 + 7] * c[3]; }
                g = xsum32(g);
                if (g > v1) { v3 = v2; i3 = i2; v2 = v1; i2 = i1; v1 = g; i1 = j; } else if (g > v2) { v3 = v2; i3 = i2; v2 = g; i2 = j; } else if (g > v3) { v3 = g; i3 = j; }
            }
            selmask = (1u << i1) | (1u << i2) | (1u << i3);
        }
    }
    if (MODE == 2 && lane == 0) *(LAS unsigned*)(L + FLG + 4 * w) = 0u;
    float m_run = -INFINITY, l_run = 0.f, carry = 0.f; bool done = false;
    if (MODE == 0) { m_run = sinks[l * 4 + h] * 1.4426950408889634f; l_run = hi ? 0.f : 1.f; }
    f32x16 o[2];
#pragma unroll
    for (int r = 0; r < 16; ++r) { o[0][r] = 0.f; o[1][r] = 0.f; }
    ATT_WRITE(0);
    for (int it = 0; it < nt; ++it) {
        if (it + 1 < nt) ATT_LOAD(it + 1);
        WG_BAR();
        if (MODE == 2) { const v4u f0 = *(const LAS v4u*)(L + FLG), f1 = *(const LAS v4u*)(L + FLG + 16); if ((f0.x & f0.y & f0.z & f0.w & f1.x & f1.y & f1.z & f1.w) != 0u) break; }
        const int kt = ATT_KT(it), buf = it & 1;
        bool rel;
        if (MODE == 0) rel = (64 * kt + 63 >= qw0 - 127) && (64 * kt <= qw0 + 31);
        else if (MODE == 1) rel = ((kt >> 2) == qb) ? (64 * kt <= qw0 + 31) : (__ballot((selmask >> (kt >> 2)) & 1u) != 0ull);
        else rel = (64 * kt <= qw0 + 30) && !done;
        if (rel) {
            const LAS unsigned char* Kb = L + KOFF + buf * 8192; const LAS unsigned char* Vb = L + VOFF + buf * 8192;
            f32x16 p0, p1;
#pragma unroll
            for (int r = 0; r < 16; ++r) { p0[r] = 0.f; p1[r] = 0.f; }
#pragma unroll
            for (int d0 = 0; d0 < 4; ++d0) { const bf16x8 k0 = lds_row8(Kb + kimg(kperm(iq), 2 * d0 + hi)), k1 = lds_row8(Kb + kimg(32 + kperm(iq), 2 * d0 + hi)); p0 = MFMA32(k0, qf[d0], p0); p1 = MFMA32(k1, qf[d0], p1); }
            const int key0 = 64 * kt + 16 * hi;
            unsigned pw[16];
            if (MODE != 2) {
                if (MODE == 0) {
#pragma unroll
                    for (int r = 0; r < 16; ++r) { const int ka = key0 + r, kb2 = key0 + 32 + r; if (!(ka <= query && query - ka < 128)) p0[r] = -INFINITY; if (!(kb2 <= query && query - kb2 < 128)) p1[r] = -INFINITY; }
                } else {
                    if ((kt >> 2) == qb) {
#pragma unroll
                        for (int r = 0; r < 16; ++r) { if (key0 + r > query) p0[r] = -INFINITY; if (key0 + 32 + r > query) p1[r] = -INFINITY; }
                    } else if (!((selmask >> (kt >> 2)) & 1u)) {
#pragma unroll
                        for (int r = 0; r < 16; ++r) { p0[r] = -INFINITY; p1[r] = -INFINITY; }
                    }
                }
                float tm = fmaxf(p0[0], p1[0]);
#pragma unroll
                for (int r = 1; r < 16; ++r) tm = fmaxf(tm, fmaxf(p0[r], p1[r]));
                { auto rr = __builtin_amdgcn_permlane32_swap(__float_as_uint(tm), __float_as_uint(tm), false, false); tm = fmaxf(__uint_as_float(rr[0]), __uint_as_float(rr[1])); }
                const float mnew = fmaxf(m_run, tm), msafe = (mnew == -INFINITY) ? 0.f : mnew;
                const float sc = __builtin_amdgcn_exp2f(m_run - msafe);
                float ls = 0.f;
#pragma unroll
                for (int r = 0; r < 16; ++r) { p0[r] = __builtin_amdgcn_exp2f(p0[r] - msafe); p1[r] = __builtin_amdgcn_exp2f(p1[r] - msafe); ls += p0[r] + p1[r]; }
                l_run = l_run * sc + ls; m_run = mnew;
#pragma unroll
                for (int r = 0; r < 16; ++r) { o[0][r] *= sc; o[1][r] *= sc; }
            } else {
                float t0 = 0.f, t1 = 0.f;
#pragma unroll
                for (int r = 15; r >= 0; --r) {
                    { const float z = p0[r]; const bool v = key0 + r < query; const float sp = fmaxf(z, 0.f) + __builtin_amdgcn_logf(1.f + __builtin_amdgcn_exp2f(-fabsf(z))); t0 += v ? -sp : 0.f; p0[r] = v ? z + t0 : -INFINITY; }
                    { const float z = p1[r]; const bool v = key0 + 32 + r < query; const float sp = fmaxf(z, 0.f) + __builtin_amdgcn_logf(1.f + __builtin_amdgcn_exp2f(-fabsf(z))); t1 += v ? -sp : 0.f; p1[r] = v ? z + t1 : -INFINITY; }
                }
                float x0, x1;
                { auto rr = __builtin_amdgcn_permlane32_swap(__float_as_uint(t0), __float_as_uint(t0), false, false); x0 = hi ? __uint_as_float(rr[0]) : __uint_as_float(rr[1]); }
                { auto rr = __builtin_amdgcn_permlane32_swap(__float_as_uint(t1), __float_as_uint(t1), false, false); x1 = hi ? __uint_as_float(rr[0]) : __uint_as_float(rr[1]); }
                const float after1 = carry + (hi ? 0.f : x1), after0 = carry + t1 + x1 + (hi ? 0.f : x0);
#pragma unroll
                for (int r = 0; r < 16; ++r) { p0[r] = __builtin_amdgcn_exp2f(p0[r] + after0); p1[r] = __builtin_amdgcn_exp2f(p1[r] + after1); }
                carry += (t0 + t1) + (x0 + x1);
                done = __all(carry < -151.0f) != 0;
            }
#pragma unroll
            for (int r = 0; r < 16; r += 2) { pw[r >> 1] = pk_bf16(p0[r], p0[r + 1]); pw[8 + (r >> 1)] = pk_bf16(p1[r], p1[r + 1]); }
#pragma unroll
            for (int ps = 0; ps < 4; ++ps) { const bf16x8 pf = __builtin_bit_cast(bf16x8, (v4u){pw[4 * ps], pw[4 * ps + 1], pw[4 * ps + 2], pw[4 * ps + 3]});
#pragma unroll
                for (int eb = 0; eb < 2; ++eb) { const bf16x8 vf = lds_tr8(Vb + tr_lane_off(lane, 32 * (ps >> 1) + 16 * hi + 8 * (ps & 1), eb)); o[eb] = MFMA32(vf, pf, o[eb]); } }
        }
        if (MODE == 2) { if (lane == 0) *(LAS unsigned*)(L + FLG + 4 * w) = (done || 64 * kt <= 0) ? 1u : 0u; }
        if (it + 1 < nt) ATT_WRITE((it + 1) & 1);
    }
    float inv = 1.f;
    if (MODE != 2) { const float lt = xsum32(l_run); inv = 1.0f / lt; }
    bf16* op = MX + (rowbase + query) * DM + ocol;
#pragma unroll
    for (int eb = 0; eb < 2; ++eb)
#pragma unroll
        for (int g4 = 0; g4 < 4; ++g4) { u32x2m ov; ov.x = pk_bf16(o[eb][4 * g4] * inv, o[eb][4 * g4 + 1] * inv); ov.y = pk_bf16(o[eb][4 * g4 + 2] * inv, o[eb][4 * g4 + 3] * inv);
            *(GAS u32x2m*)(op + 32 * eb + 8 * g4 + 4 * hi) = ov; }
    WG_BAR();
#undef ATT_KT
#undef ATT_LOAD
#undef ATT_WRITE
}

constexpr int NU_D = 64, NU_B = 1024, NU_C = 1024, NU_A = 1024;
__device__ __forceinline__ void mixer_phase(Frame& F, int l, const float* sinks) {
    for (;;) {
        if (F.tid == 0) F.MISC[0] = __hip_atomic_fetch_add((unsigned*)(F.ctl + CW_Q + 64 * l), 1u, __ATOMIC_RELAXED, __HIP_MEMORY_SCOPE_AGENT);
        WG_BAR(); int t = (int)F.MISC[0]; WG_BAR();
        if (t < NU_D) { ret_chain(F, t >> 2, t & 3); continue; } t -= NU_D;
        if (t < NU_B) { attn_unit<1>(F, l, sinks, (t & 63) >> 2, t & 3, 15 - (t >> 6)); continue; } t -= NU_B;
        if (t < NU_C) { attn_unit<2>(F, l, sinks, (t & 63) >> 2, t & 3, 15 - (t >> 6)); continue; } t -= NU_C;
        if (t < NU_A) { attn_unit<0>(F, l, sinks, (t & 63) >> 2, t & 3, 15 - (t >> 6)); continue; }
        break;
    }
}

#ifndef EN_IN
#define EN_IN 1
#endif
#ifndef EN_MIX
#define EN_MIX 1
#endif
#ifndef EN_OUT
#define EN_OUT 1
#endif
#ifndef EN_UP
#define EN_UP 1
#endif
#ifndef EN_DN
#define EN_DN 1
#endif
#ifndef EN_P0
#define EN_P0 1
#endif
#ifndef EN_FIN
#define EN_FIN 1
#endif

struct Args { const float* in[10]; float* out; unsigned char* ws; int ph_lo, ph_hi, pad0, pad1; };
__global__ void __launch_bounds__(NWAVES * 64, 2) hymba_fwd(Args args) {
    extern __shared__ __attribute__((aligned(16))) unsigned char lds[];
    Frame F;
    F.lds = (LAS unsigned char*)lds;
    F.MISC = (volatile LAS unsigned*)(F.lds + MISC_OFF);
    F.tid = threadIdx.x; F.lane = F.tid & 63; F.wave = __builtin_amdgcn_readfirstlane(F.tid >> 6);
    F.G = gridDim.x; { const int bx = blockIdx.x; F.vcu = (F.G % 8 == 0) ? (bx % 8) * (F.G / 8) + bx / 8 : bx; }
    F.ws = args.ws; F.ctl = (gu32*)(args.ws + WS_CTL);
    for (int u = F.tid; u < (LDS_BYTES - LDSCTL_OFF) / 4; u += NWAVES * 64) ((LAS unsigned*)(F.lds + LDSCTL_OFF))[u] = 0u;
    __syncthreads();
    XcdBarrier bar; bar.bar = (unsigned*)(F.ctl + CW_BAR); bar.x = 0; bar.st = nullptr;
    if (MK_ONE_LAUNCH) bar = xcd_barrier_post((unsigned*)(F.ctl + CW_BAR), F.MISC + 8);
    int lo = args.ph_lo, hi = args.ph_hi;
#define IN(k) (lo <= (k) && (k) < hi)
#define SEAM(k) do { if (IN(k) && IN((k) + 1)) xcd_barrier(bar); LAUNDER(); } while (0)
#define LAUNDER() do { asm volatile("" : "+v"(F.tid), "+s"(F.ws), "+s"(F.vcu), "+s"(F.G), "+s"(lo), "+s"(hi)); F.lane = F.tid & 63; F.wave = __builtin_amdgcn_readfirstlane(F.tid >> 6); F.ctl = (gu32*)(F.ws + WS_CTL); } while (0)

    if (IN(0) && EN_P0) { p0_prologue(F, args.in[0], args.in[1], args.in[3], args.in[4], args.in[5], args.in[6], args.in[7], args.in[8], args.in[9]); } SEAM(0);

    for (int l_ = 0; l_ < DEPTH; ++l_) { int l = l_;
        asm volatile("" : "+s"(l)); const int pb = 1 + 5 * l;
        if (IN(pb) && EN_IN) {
            pg8::Gemm g{(const bf16*)(F.ws + WS_XB), w_in_t(F, l), M, NIN, DM}; pg8::StaticOrder S; S.init(M, NIN, F.G, (int)blockIdx.x);
            pg8::EpiIn E{F.ws, l ? st_buf(F, l - 1, 1) : nullptr, l};
            pg8::gemm_phase<pg8::EpiIn, pg8::StaticOrder, true, true>(F.lds + RING_OFF, g, S, E);
        }
        SEAM(pb);
        if (IN(pb + 1) && EN_MIX) {
            if (l == 0) finalize_vecs(F);
            mixer_phase(F, l, args.in[2]);
        }
        SEAM(pb + 1);
        if (IN(pb + 2) && EN_OUT) {
            pg8::Gemm g{(const bf16*)(F.ws + WS_MIXED), w_out_t(F, l), M, DM, DM}; pg8::StaticOrder S; S.init(M, DM, F.G, (int)blockIdx.x);
            pg8::EpiRes E{F.ws, args.in[0], l ? args.in[8] + (l - 1) * DM : nullptr, l ? args.in[9] + (l - 1) * DM : nullptr, l ? 1 : 0, (int)(WS_XB >> 20), (int)(WS_Y1 >> 20), (int)(WS_ST >> 20) + 2 * (2 * (l ? l - 1 : 0) + 1), (int)(WS_ST >> 20) + 2 * (2 * l)};
            pg8::gemm_phase<pg8::EpiRes, pg8::StaticOrder, true, true>(F.lds + RING_OFF, g, S, E);
        }
        SEAM(pb + 2);
        if (IN(pb + 3) && EN_UP) {
            pg8::Gemm g{(const bf16*)(F.ws + WS_Y1), w_up_t(F, l), M, FF, DM}; pg8::StaticOrder S; S.init(M, FF, F.G, (int)blockIdx.x);
            pg8::EpiUp E{F.ws, st_buf(F, l, 0), l};
            pg8::gemm_phase<pg8::EpiUp, pg8::StaticOrder, true, true>(F.lds + RING_OFF, g, S, E);
        }
        SEAM(pb + 3);
        if (IN(pb + 4) && EN_DN) {
            pg8::Gemm g{(const bf16*)(F.ws + WS_HID), w_down_t(F, l), M, DM, FF}; pg8::StaticOrder S; S.init(M, DM, F.G, (int)blockIdx.x);
            pg8::EpiRes E{F.ws, nullptr, args.in[4] + l * DM, args.in[5] + l * DM, 1, (int)(WS_Y1 >> 20), (int)(WS_XB >> 20), (int)(WS_ST >> 20) + 2 * (2 * l), (int)(WS_ST >> 20) + 2 * (2 * l + 1)};
            pg8::gemm_phase<pg8::EpiRes, pg8::StaticOrder, true, true>(F.lds + RING_OFF, g, S, E);
        }
        SEAM(pb + 4);
    }
    if (IN(11) && EN_FIN) final_ln(F, args.out, (const bf16*)(F.ws + WS_XB), st_buf(F, DEPTH - 1, 1), args.in[8] + (DEPTH - 1) * DM, args.in[9] + (DEPTH - 1) * DM);
#undef IN
#undef SEAM
}

extern "C" void kernel_launch(void* const* d_in, const int* in_sizes, int n_in, void* d_out, int out_size, void* d_ws, size_t ws_size, hipStream_t stream) {
    static int grid = 0;
    if (grid == 0) {
        if (n_in != 10 || in_sizes[0] != M * DM || out_size != M * DM || ws_size < WS_END) { fprintf(stderr, "kernel_launch: unexpected shapes (n_in %d, in0 %d, out %d, ws %zu); nothing launched\n", n_in, n_in > 0 ? in_sizes[0] : -1, out_size, ws_size); grid = -1; return; }
        int dev = 0, cus = 0, per_cu = 0;
        if (hipGetDevice(&dev) != hipSuccess || hipDeviceGetAttribute(&cus, hipDeviceAttributeMultiprocessorCount, dev) != hipSuccess) { grid = -1; return; }
        if (hipFuncSetAttribute((const void*)hymba_fwd, hipFuncAttributeMaxDynamicSharedMemorySize, LDS_BYTES) != hipSuccess) { fprintf(stderr, "kernel_launch: hipFuncSetAttribute failed\n"); grid = -1; return; }
        if (hipOccupancyMaxActiveBlocksPerMultiprocessor(&per_cu, (const void*)hymba_fwd, NWAVES * 64, LDS_BYTES) != hipSuccess || per_cu < 1)
            fprintf(stderr, "kernel_launch: note: occupancy query reports %d workgroups per CU\n", per_cu);
        (void)hipGetLastError();
        grid = cus;
    }
    if (grid < 0) return;
    if (hipMemsetAsync((char*)d_ws + WS_CTL, 0, CTL_ZERO_BYTES, stream) != hipSuccess) return;
    Args a{};
    for (int i = 0; i < 10; ++i) a.in[i] = (const float*)d_in[i];
    a.out = (float*)d_out; a.ws = (unsigned char*)d_ws; a.pad0 = 0; a.pad1 = 0;
#if MK_ONE_LAUNCH
    a.ph_lo = 0; a.ph_hi = N_PHASES;
    hipLaunchKernelGGL(hymba_fwd, dim3(grid), dim3(NWAVES * 64), LDS_BYTES, stream, a);
#else
    for (int p = 0; p < N_PHASES; ++p) { a.ph_lo = p; a.ph_hi = p + 1; hipLaunchKernelGGL(hymba_fwd, dim3(grid), dim3(NWAVES * 64), LDS_BYTES, stream, a); }
#endif
}
```

```cpp
#include <hip/hip_runtime.h>
#include <cstdio>
#include <cstdint>
namespace pg8 {
#define PG8_LAS __attribute__((address_space(3)))
typedef unsigned short bf16_t;
typedef short bf16x8 __attribute__((ext_vector_type(8)));
typedef float f32x4 __attribute__((ext_vector_type(4)));
typedef unsigned u32x4 __attribute__((ext_vector_type(4)));
constexpr int BM = 256, BK = 64, HALF = 128, HTB = HALF * BK * 2  , STAGE_BYTES = 8 * HTB, NXCD = 8, WGM = 8;

__host__ __device__ __forceinline__ int lds_byte(int r, int c) { const int st = (r >> 4) * 2 + (c >> 5), rr = r & 15, cc = c & 31, ob = rr * 64 + cc * 2; return st * 1024 + (ob ^ (((ob >> 9) & 1) << 5)); }
__host__ __device__ __forceinline__ void stage_rc(int b, int& R, int& C) { const int st = b / 1024, sb = b % 1024, swz = sb ^ (((sb >> 9) & 1) << 5); R = (st >> 1) * 16 + swz / 64; C = (st & 1) * 32 + (swz % 64) / 2; }
__host__ __device__ __forceinline__ int perm32(int rho) { const int n = rho >> 4, i = rho & 15; return 8 * (i >> 2) + 4 * n + (i & 3); }

struct Unit { int pm, pn; };
struct Gemm { const bf16_t* A; const bf16_t* Bt; int M, N, K; };

struct StaticOrder {
    int nM, nN, nwg, G, c;
    __host__ __device__ void init(int M, int N, int G_, int c_) { nM = M / BM; nN = N / BM; nwg = nM * nN; G = G_; c = c_; }
    __host__ __device__ bool next(int i, Unit& u) const {
        const long L = (long)i * G + c; if (L >= nwg) return false;
        int wgid = (int)L; { const int q = nwg / NXCD, r = nwg % NXCD, xcd = wgid % NXCD, off = wgid / NXCD; wgid = (xcd < r ? xcd * (q + 1) : r * (q + 1) + (xcd - r) * q) + off; }
        const int nig = WGM * nN, gid = wgid / nig, fm = gid * WGM, gsz = (nM - fm) < WGM ? (nM - fm) : WGM;
        u.pm = fm + ((wgid % nig) % gsz); u.pn = (wgid % nig) / gsz; return true;
    }
    __device__ __forceinline__ void a_ready(const Unit&) const {}
    __device__ __forceinline__ void done(const Unit&) const {}
};

__device__ __forceinline__ unsigned cvt_pk_bf16(float lo, float hi) { unsigned r; asm volatile("v_cvt_pk_bf16_f32 %0, %1, %2" : "=v"(r) : "v"(lo), "v"(hi)); return r; }
#define PG8_GAS __attribute__((address_space(1)))
typedef float f32x2 __attribute__((ext_vector_type(2)));
typedef unsigned u32x2 __attribute__((ext_vector_type(2)));
template <int X> __device__ __forceinline__ float swz_xor(float v) { static_assert(X >= 1 && X <= 16, "bitmode swizzle inside 32 lanes"); return __uint_as_float((unsigned)__builtin_amdgcn_ds_swizzle((int)__float_as_uint(v), (X << 10) | 0x1f)); }
__device__ __forceinline__ float add_xor32(float v) { auto rr = __builtin_amdgcn_permlane32_swap(__float_as_uint(v), __float_as_uint(v), false, false); return __uint_as_float(rr[0]) + __uint_as_float(rr[1]); }
constexpr float LN_EPS_F = 1e-5f;
constexpr size_t EPI_WS_COS = 1u << 20, EPI_WS_KPART = 2u << 20, EPI_WS_VEC = (2u << 20) + 512 * 1024, EPI_WS_PROJ = 320ull << 20, EPI_WS_HID = 320ull << 20;
constexpr int EPI_TAB_OFF = 131072, EPI_TAB2_OFF = 139264, EPI_TAB3_OFF = 147456;
constexpr size_t EPI_WS_NEUT = (2u << 20) + 512 * 1024 + 128 * 1024;
constexpr float ALPHA_F = 1.41421356237309515f;
constexpr float QK_C2 = 0.125f * 1.4426950408889634f;
__device__ __forceinline__ void row_stats(const float* st, int row, float& mu, float& rs) {
    const f32x4 a = *(const PG8_GAS f32x4*)(st + (size_t)row * 8), b = *(const PG8_GAS f32x4*)(st + (size_t)row * 8 + 4);
    const float s = (a[0] + a[2]) + (b[0] + b[2]), q = (a[1] + a[3]) + (b[1] + b[3]);
    mu = s * (1.f / 1024.f); const float var = fmaxf(q * (1.f / 1024.f) - mu * mu, 0.f);
    rs = 1.0f / sqrtf(var + LN_EPS_F);
}
__device__ __forceinline__ f32x2 row_ms(const Unit& u, int pm0, int rowt) {
    extern __shared__ __attribute__((aligned(16))) unsigned char lds_all[];
    return *(const PG8_LAS f32x2*)((PG8_LAS unsigned char*)lds_all + EPI_TAB2_OFF + ((((u.pm - pm0) >> 3) & 3) * 256 + rowt) * 8);
}
__device__ __forceinline__ f32x4 vec_ld(const Unit& u, int pn0, int which, int c) {
    extern __shared__ __attribute__((aligned(16))) unsigned char lds_all[];
    return *(const PG8_LAS f32x4*)((PG8_LAS unsigned char*)lds_all + EPI_TAB3_OFF + (((((u.pn - pn0) >> 2) & 3) * 2 + which) * 256 + c) * 4);
}
struct EpiIn {
    static constexpr bool PERM = true, AFTER_DRAIN = false; static constexpr int MIN_STORES = 16;
    unsigned char* ws; int l, pm0, pn0;
    template <bool ROPE> __device__ __forceinline__ void rows(const f32x4 (&acc)[2][2][4][2], const Unit& u, int wr, int wc, int fr, int fq, float sc, bool km, f32x4 (&ks)[2][2]) const {
        bf16_t* P = (bf16_t*)(ws + EPI_WS_PROJ);
        const float* ctab = (const float*)(ws + EPI_WS_COS) + 8 * fq;
        const int jc = wc * 32 + 8 * fq;
        f32x4 csv[2][2], bbv[2][2];
#pragma unroll
        for (int bj = 0; bj < 2; ++bj)
#pragma unroll
            for (int n = 0; n < 2; ++n) { csv[bj][n] = vec_ld(u, pn0, 0, jc + bj * HALF + n * 4) * sc; bbv[bj][n] = vec_ld(u, pn0, 1, jc + bj * HALF + n * 4) * sc; }
#pragma unroll
        for (int ai = 0; ai < 2; ++ai)
#pragma unroll
            for (int m = 0; m < 4; ++m) {
                const int rowt = ai * HALF + wr * 64 + m * 16 + fr, row = u.pm * BM + rowt;
                const f32x2 ms = row_ms(u, pm0, rowt);
                const float rss = ms.y * sc;
                const float* cp = ctab + (row & 4095) * 32;
                bf16_t* dst = P + (size_t)row * 3072 + u.pn * BM + 64 * wc + 8 * fq;
                u32x4 w1, w2;
#pragma unroll
                for (int n = 0; n < 2; ++n) {
                    const f32x4 a1 = acc[ai][0][m][n] * rss - (ms.x * ms.y) * csv[0][n] + bbv[0][n], a2 = acc[ai][1][m][n] * rss - (ms.x * ms.y) * csv[1][n] + bbv[1][n];
                    f32x4 o1 = a1, o2 = a2;
                    if (ROPE) { const f32x4 c4 = *(const PG8_GAS f32x4*)(cp + 4 * n), s4 = *(const PG8_GAS f32x4*)(cp + 4096 * 32 + 4 * n); o1 = a1 * c4 - a2 * s4; o2 = a1 * s4 + a2 * c4; }
                    if (km) { ks[0][n] += o1; ks[1][n] += o2; }
                    if (n == 0) { w1.x = cvt_pk_bf16(o1[0], o1[1]); w1.y = cvt_pk_bf16(o1[2], o1[3]); w2.x = cvt_pk_bf16(o2[0], o2[1]); w2.y = cvt_pk_bf16(o2[2], o2[3]); }
                    else { w1.z = cvt_pk_bf16(o1[0], o1[1]); w1.w = cvt_pk_bf16(o1[2], o1[3]); w2.z = cvt_pk_bf16(o2[0], o2[1]); w2.w = cvt_pk_bf16(o2[2], o2[3]); }
                }
                *(PG8_GAS u32x4*)dst = w1; *(PG8_GAS u32x4*)(dst + 32) = w2;
                if (m & 1) asm volatile("" ::: "memory");
            }
    }
    __device__ __forceinline__ void operator()(const f32x4 (&acc)[2][2][4][2], const Unit& u, int wr, int wc, int fr_, int fq_) const {
        int fr = fr_, fq = fq_; asm volatile("" : "+v"(fr), "+v"(fq));
        float* kpart = (float*)(ws + EPI_WS_KPART);
        constexpr unsigned long long ROPE_M = 0x3FULL | (0xFFULL << 8) | (0xFFULL << 32), C2_M = 0xFULL | (0xFULL << 8) | (0xFULL << 20), K8_M = 0xFULL << 36;
        const int G = 4 * u.pn + wc;
        const bool rope = (ROPE_M >> G) & 1ULL;
        const float sc = ((C2_M >> G) & 1ULL) ? QK_C2 : (((K8_M >> G) & 1ULL) ? 0.125f : 1.f);
        const bool km = (u.pn == 3);
        f32x4 ks[2][2];
#pragma unroll
        for (int bj = 0; bj < 2; ++bj) { ks[bj][0] = (f32x4){0.f, 0.f, 0.f, 0.f}; ks[bj][1] = (f32x4){0.f, 0.f, 0.f, 0.f}; }
        if (rope) rows<true>(acc, u, wr, wc, fr, fq, sc, km, ks); else rows<false>(acc, u, wr, wc, fr, fq, sc, false, ks);
        if (km) {
#pragma unroll
            for (int bj = 0; bj < 2; ++bj)
#pragma unroll
                for (int n = 0; n < 2; ++n)
#pragma unroll
                    for (int e = 0; e < 4; ++e) { float v = ks[bj][n][e]; v += swz_xor<1>(v); v += swz_xor<2>(v); v += swz_xor<4>(v); v += swz_xor<8>(v); ks[bj][n][e] = v; }
            if (fr == 0) {
                float* kp = kpart + (size_t)(u.pm * 2 + wr) * 256 + 64 * wc + 8 * fq;
#pragma unroll
                for (int bj = 0; bj < 2; ++bj) { *(PG8_GAS f32x4*)(kp + 32 * bj) = ks[bj][0]; *(PG8_GAS f32x4*)(kp + 32 * bj + 4) = ks[bj][1]; }
            }
        }
    }
};
struct EpiRes {
    static constexpr bool PERM = true, AFTER_DRAIN = false; static constexpr int MIN_STORES = 16;
    unsigned char* ws; int mode, ysrc_mib, ydst_mib, sto_mib, pm0, pn0;
    __device__ __forceinline__ void operator()(const f32x4 (&acc)[2][2][4][2], const Unit& u, int wr, int wc, int fr_, int fq_) const {
        int fr = fr_, fq = fq_; asm volatile("" : "+v"(fr), "+v"(fq));
        const bf16_t* yprev = (const bf16_t*)(ws + ((size_t)ysrc_mib << 20)); bf16_t* Y = (bf16_t*)(ws + ((size_t)ydst_mib << 20));
        float* sto = (float*)(ws + ((size_t)sto_mib << 20));
        extern __shared__ __attribute__((aligned(16))) unsigned char lds_all[];
        PG8_LAS unsigned char* tab = (PG8_LAS unsigned char*)lds_all + EPI_TAB_OFF;
        const int c0 = u.pn * BM + wc * 32 + 8 * fq;
        f32x4 wv[2][2], bv[2][2];
#pragma unroll
        for (int bj = 0; bj < 2; ++bj)
#pragma unroll
            for (int n = 0; n < 2; ++n) { wv[bj][n] = vec_ld(u, pn0, 0, wc * 32 + 8 * fq + bj * HALF + 4 * n); bv[bj][n] = vec_ld(u, pn0, 1, wc * 32 + 8 * fq + bj * HALF + 4 * n); }
        PG8_LAS f32x2* T = (PG8_LAS f32x2*)tab;
#pragma unroll
        for (int ai = 0; ai < 2; ++ai)
#pragma unroll
            for (int m = 0; m < 4; ++m) {
                const int rowt = ai * HALF + wr * 64 + m * 16 + fr, row = u.pm * BM + rowt;
                const f32x2 ms = row_ms(u, pm0, rowt);
                float s = 0.f, q = 0.f;
#pragma unroll
                for (int bj = 0; bj < 2; ++bj) {
                    const size_t off = (size_t)row * 1024 + c0 + bj * HALF;
                    const u32x4 yb = *(const PG8_GAS u32x4*)(yprev + off);
                    f32x4 r0 = (f32x4){__uint_as_float(yb.x << 16), __uint_as_float(yb.x & 0xffff0000u), __uint_as_float(yb.y << 16), __uint_as_float(yb.y & 0xffff0000u)};
                    f32x4 r1 = (f32x4){__uint_as_float(yb.z << 16), __uint_as_float(yb.z & 0xffff0000u), __uint_as_float(yb.w << 16), __uint_as_float(yb.w & 0xffff0000u)};
                    r0 = (r0 - ms.x) * ms.y * wv[bj][0] + bv[bj][0]; r1 = (r1 - ms.x) * ms.y * wv[bj][1] + bv[bj][1];
                    const f32x4 v0 = r0 * ALPHA_F + acc[ai][bj][m][0], v1 = r1 * ALPHA_F + acc[ai][bj][m][1];
                    s += ((v0[0] + v0[1]) + (v0[2] + v0[3])) + ((v1[0] + v1[1]) + (v1[2] + v1[3]));
                    q += ((v0[0] * v0[0] + v0[1] * v0[1]) + (v0[2] * v0[2] + v0[3] * v0[3])) + ((v1[0] * v1[0] + v1[1] * v1[1]) + (v1[2] * v1[2] + v1[3] * v1[3]));
                    u32x4 w; w.x = cvt_pk_bf16(v0[0], v0[1]); w.y = cvt_pk_bf16(v0[2], v0[3]); w.z = cvt_pk_bf16(v1[0], v1[1]); w.w = cvt_pk_bf16(v1[2], v1[3]);
                    *(PG8_GAS u32x4*)(Y + off) = w;
                }
                s += swz_xor<16>(s); s = add_xor32(s); q += swz_xor<16>(q); q = add_xor32(q);
                if (fq == 0) T[rowt * 4 + wc] = (f32x2){s, q};
                if (m & 1) asm volatile("" ::: "memory");
            }
        asm volatile("s_waitcnt lgkmcnt(0)" ::: "memory"); __builtin_amdgcn_s_barrier(); asm volatile("" ::: "memory");
        const int tid = (wr * 4 + wc) * 64 + fq * 16 + fr;
        if (tid < 256) { const f32x4 a = *(const PG8_LAS f32x4*)(tab + tid * 32), b = *(const PG8_LAS f32x4*)(tab + tid * 32 + 16);
            *(PG8_GAS f32x2*)(sto + (size_t)(u.pm * BM + tid) * 8 + u.pn * 2) = (f32x2){(a[0] + a[2]) + (b[0] + b[2]), (a[1] + a[3]) + (b[1] + b[3])}; }
    }
};
struct EpiUp {
    static constexpr bool PERM = true, AFTER_DRAIN = false; static constexpr int MIN_STORES = 16;
    unsigned char* ws; int l, pm0, pn0;
    __device__ __forceinline__ void operator()(const f32x4 (&acc)[2][2][4][2], const Unit& u, int wr, int wc, int fr_, int fq_) const {
        int fr = fr_, fq = fq_; asm volatile("" : "+v"(fr), "+v"(fq));
        bf16_t* H = (bf16_t*)(ws + EPI_WS_HID);
        const int c0 = u.pn * BM + wc * 32 + 8 * fq;
        f32x4 csv[2][2], bbv[2][2];
#pragma unroll
        for (int bj = 0; bj < 2; ++bj)
#pragma unroll
            for (int n = 0; n < 2; ++n) { csv[bj][n] = vec_ld(u, pn0, 0, wc * 32 + 8 * fq + bj * HALF + 4 * n); bbv[bj][n] = vec_ld(u, pn0, 1, wc * 32 + 8 * fq + bj * HALF + 4 * n); }
#pragma unroll
        for (int ai = 0; ai < 2; ++ai)
#pragma unroll
            for (int m = 0; m < 4; ++m) {
                const int rowt = ai * HALF + wr * 64 + m * 16 + fr, row = u.pm * BM + rowt;
                const f32x2 ms = row_ms(u, pm0, rowt);
#pragma unroll
                for (int bj = 0; bj < 2; ++bj) {
                    f32x4 v0 = (acc[ai][bj][m][0] - ms.x * csv[bj][0]) * ms.y + bbv[bj][0], v1 = (acc[ai][bj][m][1] - ms.x * csv[bj][1]) * ms.y + bbv[bj][1];
#pragma unroll
                    for (int e = 0; e < 4; ++e) { const float a = fmaxf(v0[e], 0.f), b = fmaxf(v1[e], 0.f); v0[e] = a * a; v1[e] = b * b; }
                    u32x4 w; w.x = cvt_pk_bf16(v0[0], v0[1]); w.y = cvt_pk_bf16(v0[2], v0[3]); w.z = cvt_pk_bf16(v1[0], v1[1]); w.w = cvt_pk_bf16(v1[2], v1[3]);
                    *(PG8_GAS u32x4*)(H + (size_t)row * 4096 + c0 + bj * HALF) = w;
                }
            }
    }
};

template <class Epi, class Sched, bool ALIGN_EPI = false, bool SP2 = false>
__device__ __forceinline__ void gemm_phase(PG8_LAS unsigned char* lds, const Gemm g, const Sched& S, const Epi& E, const int wave_s) {
    unsigned ones_ = ~0u; asm volatile("" : "+s"(ones_)); const int tid_ = wave_s * 64 + (int)__builtin_amdgcn_mbcnt_hi(ones_, __builtin_amdgcn_mbcnt_lo(ones_, 0u));
    const int tid = tid_, wid = __builtin_amdgcn_readfirstlane(tid >> 6), lane = tid & 63, wr = wid >> 2, wc = wid & 3, fr = lane & 15, fq = lane >> 4;
    const int K = g.K, nt = K / BK;
    unsigned voffA[2], voffB[2];
#pragma unroll
    for (int i = 0; i < 2; ++i) { int R, C; stage_rc(tid * 16 + i * 8192, R, C); const int Rb = Epi::PERM ? ((R & ~31) + perm32(R & 31)) : R;
        voffA[i] = (unsigned)(R * K + C) * 2u; voffB[i] = (unsigned)(Rb * K + C) * 2u; }
    const size_t kstep = (size_t)(BK * 2);
    const size_t hstep = (size_t)HALF * K * 2;
    const size_t tstep = 2 * hstep;
    const unsigned ldsw = (unsigned)wid * 1024u;
    const int aoff = lds_byte(wr * 64 + fr, fq * 8), boff = lds_byte(wc * 32 + fr, fq * 8);
#define PG8_SA(b, h) (((b) * 2 + (h)) * HTB)
#define PG8_SB(b, h) ((4 + (b) * 2 + (h)) * HTB)
#define PG8_STAGE(bufoff, gbase, voff) do { _Pragma("unroll") for (int _i = 0; _i < 2; ++_i) \
        __builtin_amdgcn_global_load_lds((const unsigned*)((const char*)(gbase) + (voff)[_i]), (PG8_LAS unsigned*)(lds + (bufoff) + ldsw + _i * 8192), 16, 0, 0); } while (0)
#define PG8_LDA(dst, b, h) do { _Pragma("unroll") for (int m = 0; m < 4; ++m) _Pragma("unroll") for (int k = 0; k < 2; ++k) dst[m][k] = *(const PG8_LAS bf16x8*)(lds + PG8_SA(b, h) + aoff + m * 2048 + k * 1024); } while (0)
#define PG8_LDB(dst, b, h) do { _Pragma("unroll") for (int n = 0; n < 2; ++n) _Pragma("unroll") for (int k = 0; k < 2; ++k) dst[n][k] = *(const PG8_LAS bf16x8*)(lds + PG8_SB(b, h) + boff + n * 2048 + k * 1024); } while (0)
#define PG8_MMA(ai, bj, At, Bt) do { __builtin_amdgcn_s_setprio(1); _Pragma("unroll") for (int m = 0; m < 4; ++m) _Pragma("unroll") for (int n = 0; n < 2; ++n) _Pragma("unroll") for (int k = 0; k < 2; ++k) \
        acc[ai][bj][m][n] = __builtin_amdgcn_mfma_f32_16x16x32_bf16(Bt[n][k], At[m][k], acc[ai][bj][m][n], 0, 0, 0); __builtin_amdgcn_s_setprio(0); } while (0)
#define PG8_WAIT_V(n) asm volatile("s_waitcnt vmcnt(" #n ")" ::: "memory")
#define PG8_WAIT_L(n) asm volatile("s_waitcnt lgkmcnt(" #n ")" ::: "memory")
#define PG8_BAR __builtin_amdgcn_s_barrier()
#define PG8_SCHED __builtin_amdgcn_sched_barrier(0)
    Unit cur, nxt; int ui = 0;
    if (!S.next(0, cur)) return;
    f32x4 acc[2][2][4][2];
#pragma unroll
    for (int a = 0; a < 2; ++a)
#pragma unroll
        for (int b = 0; b < 2; ++b)
#pragma unroll
            for (int m = 0; m < 4; ++m)
#pragma unroll
                for (int n = 0; n < 2; ++n) acc[a][b][m][n] = (f32x4){0.f, 0.f, 0.f, 0.f};
    bf16x8 At[4][2], B0[2][2], B1[2][2];
    const char* cA = (const char*)g.A + (size_t)cur.pm * tstep; const char* cB = (const char*)g.Bt + (size_t)cur.pn * tstep;
    S.a_ready(cur);
    if constexpr (SP2) {
        PG8_STAGE(PG8_SB(0, 0), cB, voffB); PG8_STAGE(PG8_SB(0, 1), cB + hstep, voffB); PG8_STAGE(PG8_SA(0, 0), cA, voffA); PG8_STAGE(PG8_SA(0, 1), cA + hstep, voffA);
        if (wr == 1) PG8_BAR;
        PG8_WAIT_V(2); PG8_BAR;
        PG8_STAGE(PG8_SB(1, 0), cB + kstep, voffB); PG8_STAGE(PG8_SA(1, 0), cA + kstep, voffA); PG8_STAGE(PG8_SB(1, 1), cB + hstep + kstep, voffB);
        PG8_WAIT_V(6); PG8_BAR;
    } else {
        PG8_STAGE(PG8_SB(0, 0), cB, voffB); PG8_STAGE(PG8_SA(0, 0), cA, voffA); PG8_STAGE(PG8_SB(0, 1), cB + hstep, voffB); PG8_STAGE(PG8_SA(0, 1), cA + hstep, voffA);
        if (wr == 1) PG8_BAR;
        PG8_WAIT_V(4); PG8_BAR;
        PG8_STAGE(PG8_SB(1, 0), cB + kstep, voffB); PG8_STAGE(PG8_SA(1, 0), cA + kstep, voffA); PG8_STAGE(PG8_SB(1, 1), cB + hstep + kstep, voffB);
        PG8_WAIT_V(6); PG8_BAR;
    }
    for (;;) {
        const bool has_next = S.next(ui + 1, nxt);
        const char* nA = has_next ? (const char*)g.A + (size_t)nxt.pm * tstep : cA; const char* nB = has_next ? (const char*)g.Bt + (size_t)nxt.pn * tstep : cB;
        for (int t = 0; t < nt; t += 2) {
            const bool last = (t == nt - 2);
            const char* a1 = cA + (size_t)(t + 1) * kstep;
            const char* a2 = last ? nA : cA + (size_t)(t + 2) * kstep; const char* b2 = last ? nB : cB + (size_t)(t + 2) * kstep;
            const char* a3 = a2 + kstep; const char* b3 = b2 + kstep;
            if (last && has_next) S.a_ready(nxt);
            if constexpr (SP2) {
            PG8_LDB(B0, 0, 0); PG8_LDB(B1, 0, 1); PG8_SCHED; PG8_LDA(At, 0, 0); PG8_STAGE(PG8_SA(1, 1), a1 + hstep, voffA);
            PG8_WAIT_V(8); PG8_WAIT_L(0); PG8_BAR; PG8_MMA(0, 0, At, B0); PG8_MMA(0, 1, At, B1); PG8_BAR; PG8_SCHED;
            PG8_LDA(At, 0, 1); PG8_STAGE(PG8_SB(0, 0), b2, voffB); PG8_STAGE(PG8_SB(0, 1), b2 + hstep, voffB); PG8_STAGE(PG8_SA(0, 0), a2, voffA);
            PG8_WAIT_V(8); PG8_WAIT_L(0); PG8_BAR; PG8_MMA(1, 0, At, B0); PG8_MMA(1, 1, At, B1); PG8_BAR; PG8_SCHED;
            PG8_LDB(B0, 1, 0); PG8_LDB(B1, 1, 1); PG8_SCHED; PG8_LDA(At, 1, 0); PG8_STAGE(PG8_SA(0, 1), a2 + hstep, voffA);
            PG8_WAIT_V(8); PG8_WAIT_L(0); PG8_BAR; PG8_MMA(0, 0, At, B0); PG8_MMA(0, 1, At, B1); PG8_BAR; PG8_SCHED;
            PG8_LDA(At, 1, 1); PG8_STAGE(PG8_SB(1, 0), b3, voffB); PG8_STAGE(PG8_SB(1, 1), b3 + hstep, voffB); PG8_STAGE(PG8_SA(1, 0), a3, voffA);
            PG8_WAIT_V(8); PG8_WAIT_L(0); PG8_BAR; PG8_MMA(1, 0, At, B0); PG8_MMA(1, 1, At, B1); PG8_BAR; PG8_SCHED;
            } else {
            PG8_LDB(B0, 0, 0); PG8_SCHED; PG8_LDA(At, 0, 0); PG8_STAGE(PG8_SA(1, 1), a1 + hstep, voffA);
            PG8_WAIT_L(8); PG8_BAR; PG8_WAIT_L(0); PG8_MMA(0, 0, At, B0); PG8_BAR; PG8_SCHED;
            PG8_LDB(B1, 0, 1); PG8_STAGE(PG8_SB(0, 0), b2, voffB);
            PG8_BAR; PG8_WAIT_L(0); PG8_MMA(0, 1, At, B1); PG8_BAR;
            PG8_LDA(At, 0, 1); PG8_STAGE(PG8_SA(0, 0), a2, voffA);
            PG8_BAR; PG8_WAIT_L(0); PG8_MMA(1, 0, At, B0); PG8_BAR; PG8_SCHED;
            PG8_STAGE(PG8_SB(0, 1), b2 + hstep, voffB);
            PG8_WAIT_V(6); PG8_BAR; PG8_MMA(1, 1, At, B1); PG8_BAR;
            PG8_LDB(B0, 1, 0); PG8_SCHED; PG8_LDA(At, 1, 0); PG8_STAGE(PG8_SA(0, 1), a2 + hstep, voffA);
            PG8_WAIT_L(8); PG8_BAR; PG8_WAIT_L(0); PG8_MMA(0, 0, At, B0); PG8_BAR; PG8_SCHED;
            PG8_LDB(B1, 1, 1); PG8_STAGE(PG8_SB(1, 0), b3, voffB);
            PG8_BAR; PG8_WAIT_L(0); PG8_MMA(0, 1, At, B1); PG8_BAR;
            PG8_LDA(At, 1, 1); PG8_STAGE(PG8_SA(1, 0), a3, voffA);
            PG8_BAR; PG8_WAIT_L(0); PG8_MMA(1, 0, At, B0); PG8_BAR; PG8_SCHED;
            PG8_STAGE(PG8_SB(1, 1), b3 + hstep, voffB);
            PG8_WAIT_V(6); PG8_BAR; PG8_MMA(1, 1, At, B1); PG8_BAR;
            }
        }
        if constexpr (ALIGN_EPI) { if (wr == 0) PG8_BAR; }
        if constexpr (!Epi::AFTER_DRAIN) { E(acc, cur, wr, wc, fr, fq); S.done(cur); }
        if (!has_next) break;
#pragma unroll
        for (int a = 0; a < 2; ++a)
#pragma unroll
            for (int b = 0; b < 2; ++b)
#pragma unroll
                for (int m = 0; m < 4; ++m)
#pragma unroll
                    for (int n = 0; n < 2; ++n) acc[a][b][m][n] = (f32x4){0.f, 0.f, 0.f, 0.f};
        cur = nxt; cA = nA; cB = nB; ++ui;
        if constexpr (ALIGN_EPI) { if (wr == 1) PG8_BAR; }
    }
    PG8_WAIT_V(0);
    if constexpr (!ALIGN_EPI) { if (wr == 0) PG8_BAR; }
    PG8_BAR;
    if constexpr (Epi::AFTER_DRAIN) { E.fused(acc, cur, wr, wc, fr, fq, lds, wid, lane); S.done(cur); }
#undef PG8_SA
#undef PG8_SB
#undef PG8_STAGE
#undef PG8_LDA
#undef PG8_LDB
#undef PG8_MMA
#undef PG8_WAIT_V
#undef PG8_WAIT_L
#undef PG8_BAR
#undef PG8_SCHED
}
}

constexpr int NWAVES = 8;
constexpr int BATCH = 16, SEQ = 4096, DM = 1024, FF = 4096, NIN = 3072, DEPTH = 2;
constexpr int M = BATCH * SEQ;
#ifndef MK_ONE_LAUNCH
#define MK_ONE_LAUNCH 1
#endif
constexpr int N_PHASES = 12;
constexpr size_t MiB = 1u << 20;
constexpr size_t WS_CTL = 0, CTL_ZERO_BYTES = 1 * MiB;
constexpr size_t WS_COS = 1 * MiB, WS_SIN = WS_COS + 512 * 1024;
constexpr size_t WS_KPART = 2 * MiB;
constexpr size_t WS_VEC = 2 * MiB + 512 * 1024;
constexpr size_t WS_PART = 3 * MiB;
constexpr size_t WS_ST = 6 * MiB;
constexpr size_t WS_W = 16 * MiB;
constexpr size_t WS_XB = 64 * MiB;
constexpr size_t WS_Y1 = 192 * MiB;
constexpr size_t WS_PROJ = 320 * MiB;
constexpr size_t WS_MIXED = 704 * MiB;
constexpr size_t WS_HID = 320 * MiB;
constexpr size_t WS_END = 1001 * MiB;
constexpr int CW_TMO = 0, CW_CODE = 1;
constexpr int CW_BAR = 4096;
constexpr int CW_Q = 16384;
constexpr int VEC_CSIN = 0, VEC_BBIN = 2 * 3072, VEC_CSUP = 4 * 3072, VEC_BBUP = 4 * 3072 + 2 * 4096;
constexpr int PART_IN_CS = 0, PART_IN_BB = 16 * 3072, PART_UP = 32 * 3072;
constexpr int RING_OFF = 0, RING_BYTES = 131072;
constexpr int TAB_OFF = RING_BYTES;
constexpr int TAB2_OFF = RING_BYTES + 8192;
constexpr int TAB3_OFF = RING_BYTES + 16384;
constexpr int LDSCTL_OFF = RING_BYTES + 24576, MISC_OFF = LDSCTL_OFF + 320;
constexpr int LDS_BYTES = 163840;
static_assert(MISC_OFF + 128 <= LDS_BYTES, "LDS map");
static_assert(pg8::EPI_TAB_OFF == TAB_OFF && pg8::EPI_TAB2_OFF == TAB2_OFF && pg8::EPI_TAB3_OFF == TAB3_OFF && pg8::EPI_WS_NEUT == WS_VEC + 128 * 1024 && pg8::EPI_WS_COS == WS_COS && pg8::EPI_WS_KPART == WS_KPART && pg8::EPI_WS_VEC == WS_VEC && pg8::EPI_WS_PROJ == WS_PROJ && pg8::EPI_WS_HID == WS_HID && WS_SIN == WS_COS + 4096 * 32 * 4 && VEC_BBIN == VEC_CSIN + 2 * 3072 && VEC_CSUP == 4 * 3072 && VEC_BBUP == VEC_CSUP + 2 * 4096, "epilogue view of the d_ws map");
#define GAS __attribute__((address_space(1)))
#define LAS __attribute__((address_space(3)))
typedef unsigned short bf16;
typedef unsigned v4u __attribute__((ext_vector_type(4)));
typedef float f32x4 __attribute__((ext_vector_type(4)));
typedef short bf16x8 __attribute__((ext_vector_type(8)));
typedef GAS unsigned gu32;
typedef GAS unsigned long long gu64;
#define RLX_AGENT __ATOMIC_RELAXED, __HIP_MEMORY_SCOPE_AGENT
#define LDS_WAIT() asm volatile("s_waitcnt lgkmcnt(0)" ::: "memory")
#define VM_WAIT() asm volatile("s_waitcnt vmcnt(0)" ::: "memory")
__device__ __forceinline__ unsigned long long rt() { return __builtin_amdgcn_s_memrealtime(); }
__device__ __forceinline__ unsigned f2bf(float f) { unsigned u = __builtin_bit_cast(unsigned, f); return (u + 0x7fffu + ((u >> 16) & 1u)) >> 16; }
__device__ __forceinline__ unsigned pk2(float lo, float hi) { return f2bf(lo) | (f2bf(hi) << 16); }

#define XB_TMO      128
#define XB_XCNT(j)  (256  + 64 * (j))
#define XB_XSUB(j)  (1280 + 64 * (j))
#define XB_XGEN(j)  (2304 + 64 * (j))
#define XB_TOP      3328
#define XB_TOPGEN   3392
#define XCD_BAR_WORDS 3456
#define XB_SPIN_CAP (1u << 18)

__device__ __forceinline__ unsigned xb_ld(unsigned* p)              { return __hip_atomic_load(p, __ATOMIC_RELAXED, __HIP_MEMORY_SCOPE_AGENT); }
__device__ __forceinline__ unsigned xb_add(unsigned* p, unsigned v) { return __hip_atomic_fetch_add(p, v, __ATOMIC_RELAXED, __HIP_MEMORY_SCOPE_AGENT); }
__device__ __forceinline__ unsigned xb_xcc_id() { return (unsigned)__builtin_amdgcn_s_getreg((3 << 11) | 20) & 0xFu; }
#define XB_SPIN(cond, bar) do { unsigned _sp = 0; while (cond) { __builtin_amdgcn_s_sleep(1); \
    if ((++_sp & 255u) == 0u) { if (xb_ld(&(bar)[XB_TMO])) break; if (_sp > XB_SPIN_CAP) { atomicAdd(&(bar)[XB_TMO], 1u); break; } } } } while (0)

struct XcdBarrier {
    unsigned* bar; unsigned x;
    volatile LAS unsigned* st;
};

__device__ __forceinline__ XcdBarrier xcd_barrier_post(unsigned* bar, volatile LAS unsigned* st) {
    XcdBarrier b; b.bar = bar; b.x = xb_xcc_id(); b.st = st;
    if (threadIdx.x == 0) (void)xb_add(&bar[XB_XCNT(b.x)], 1u);
    return b;
}
__device__ __forceinline__ void xcd_barrier_complete(unsigned* bar, unsigned x, unsigned& nloc, unsigned& nx) {
    const unsigned G = gridDim.x * gridDim.y * gridDim.z;
    unsigned sum, cnt, mine, sp = 0u;
    for (;;) {
        sum = 0u; cnt = 0u; mine = 0u;
#pragma unroll
        for (unsigned j = 0; j < 16; ++j) { const unsigned c = xb_ld(&bar[XB_XCNT(j)]); sum += c; cnt += (c > 0u) ? 1u : 0u; mine = (j == x) ? c : mine; }
        if (sum == G) break;
        __builtin_amdgcn_s_sleep(1);
        if ((++sp & 255u) == 0u) { if (xb_ld(&bar[XB_TMO])) break; if (sp > XB_SPIN_CAP) { atomicAdd(&bar[XB_TMO], 1u); break; } }
    }
    nloc = mine > 0u ? mine : 1u; nx = cnt > 0u ? cnt : 1u;
}

__device__ __forceinline__ void xcd_barrier(const XcdBarrier& b, const bool is_t0  ) {
    asm volatile("s_waitcnt vmcnt(0)" ::: "memory");
    __syncthreads();
    if (is_t0) {
        unsigned* bar = b.bar;
        __builtin_amdgcn_s_waitcnt(0);
        unsigned nloc = b.st[0], nx = b.st[1];
        if (nloc == 0u) { xcd_barrier_complete(bar, b.x, nloc, nx); b.st[0] = nloc; b.st[1] = nx; }
        const unsigned old = xb_add(&bar[XB_XSUB(b.x)], 1u);
        const unsigned gen = old / nloc;
        if (old + 1u == (gen + 1u) * nloc) {
            __builtin_amdgcn_fence(__ATOMIC_RELEASE, "agent");
            asm volatile("s_waitcnt vmcnt(0)" ::: "memory");
            const unsigned og = xb_add(&bar[XB_TOP], 1u);
            const unsigned tg = og / nx;
            if (og + 1u == (tg + 1u) * nx) xb_add(&bar[XB_TOPGEN], 1u);
            else XB_SPIN(xb_ld(&bar[XB_TOPGEN]) == tg, bar);
            __builtin_amdgcn_fence(__ATOMIC_ACQUIRE, "agent");
            xb_add(&bar[XB_XGEN(b.x)], 1u);
            asm volatile("s_waitcnt vmcnt(0)" ::: "memory");
        } else {
            XB_SPIN(xb_ld(&bar[XB_XGEN(b.x)]) == gen, bar);
            __builtin_amdgcn_fence(__ATOMIC_ACQUIRE, "agent");
            asm volatile("s_waitcnt vmcnt(0)" ::: "memory");
        }
    }
    __syncthreads();
}

struct Frame {
    LAS unsigned char* lds;
    volatile LAS unsigned* MISC;
    gu32* ctl;
    int tid, lane, wave;
    int vcu, G;
    unsigned char* ws;
};
__device__ __forceinline__ int opaque_lane() { unsigned ones = ~0u; asm volatile("" : "+s"(ones)); return (int)__builtin_amdgcn_mbcnt_hi(ones, __builtin_amdgcn_mbcnt_lo(ones, 0u)); }
#define WG_BAR() asm volatile("s_waitcnt lgkmcnt(0)\n\ts_barrier" ::: "memory")
__device__ __forceinline__ void build_row_table(Frame& F, const float* st, int pm0) {
    typedef float f32x2t __attribute__((ext_vector_type(2)));
    LAS f32x2t* T2 = (LAS f32x2t*)(F.lds + TAB2_OFF);
#pragma unroll
    for (int k = 0; k < 2; ++k) { const int r = F.tid + NWAVES * 64 * k, pm = pm0 + 8 * (r >> 8); float mu = 0.f, rs = 1.f;
        if (st != nullptr && pm < M / 256) pg8::row_stats(st, pm * 256 + (r & 255), mu, rs);
        T2[r] = (f32x2t){mu, rs}; }
    WG_BAR();
}
__device__ __forceinline__ void build_vec_table(Frame& F, const float* v0, const float* v1, float c0, float c1, int pn0, int nN) {
    LAS float* T3 = (LAS float*)(F.lds + TAB3_OFF);
#pragma unroll
    for (int k = 0; k < 4; ++k) { const int i = F.tid + NWAVES * 64 * k, slot = i >> 9, which = (i >> 8) & 1, c = i & 255, pn = pn0 + 4 * slot; const float* v = which ? v1 : v0;
        T3[i] = (v != nullptr && pn < nN) ? ((const GAS float*)v)[pn * 256 + c] : (which ? c1 : c0); }
}
__device__ __forceinline__ float bf_round(float f) { return __uint_as_float(f2bf(f) << 16); }

__device__ __forceinline__ void p0_transpose_item(const float* W, int K, int N, bf16* WT, bool inperm, const float* lnw, const float* lnb, float* csp, float* bbp, LAS float* scr, int item, int lane) {
    const int nblk = N / 32, kb = item / nblk, nb = item % nblk, k0 = 64 * kb, n0 = 32 * nb;
    const int lr = lane >> 3, lc = lane & 7;
    f32x4 cs = (f32x4){0.f, 0.f, 0.f, 0.f}, bs = (f32x4){0.f, 0.f, 0.f, 0.f};
    f32x4 wv[8];
#pragma unroll
    for (int j = 0; j < 8; ++j) wv[j] = *(const GAS f32x4*)(W + (size_t)(k0 + lr + 8 * j) * N + n0 + 4 * lc);
#pragma unroll
    for (int j = 0; j < 8; ++j) { const int kk = lr + 8 * j; const float g = lnw ? lnw[k0 + kk] : 1.f, bl = lnb ? lnb[k0 + kk] : 0.f;
#pragma unroll
        for (int e = 0; e < 4; ++e) { const float w = wv[j][e], r = bf_round(w * g); scr[kk * 33 + 4 * lc + e] = r; cs[e] += r; bs[e] += bl * w; } }
    if (csp) {
#pragma unroll
        for (int e = 0; e < 4; ++e) { float v = cs[e]; v += pg8::swz_xor<8>(v); v += pg8::swz_xor<16>(v); v = pg8::add_xor32(v); cs[e] = v; float u2 = bs[e]; u2 += pg8::swz_xor<8>(u2); u2 += pg8::swz_xor<16>(u2); u2 = pg8::add_xor32(u2); bs[e] = u2; }
        if (lane < 8) { *(GAS f32x4*)(csp + (size_t)kb * N + n0 + 4 * lc) = cs; *(GAS f32x4*)(bbp + (size_t)kb * N + n0 + 4 * lc) = bs; } }
    LDS_WAIT(); asm volatile("" ::: "memory");
    const int c = lane & 7;
#pragma unroll
    for (int j = 0; j < 4; ++j) { const int n = (lane >> 3) + 8 * j; const LAS float* s = scr + (8 * c) * 33 + n;
        v4u o; o.x = pk2(s[0 * 33], s[1 * 33]); o.y = pk2(s[2 * 33], s[3 * 33]); o.z = pk2(s[4 * 33], s[5 * 33]); o.w = pk2(s[6 * 33], s[7 * 33]);
        int orow = n0 + n; if (inperm) orow = (orow & ~0xE0) | ((orow & 0x20) << 2) | ((orow & 0xC0) >> 1);
        *(GAS v4u*)(WT + (size_t)orow * K + k0 + 8 * c) = o; }
    LDS_WAIT(); asm volatile("" ::: "memory");
}
__device__ __forceinline__ bf16* w_in_t(Frame& F, int l) { return (bf16*)(F.ws + WS_W + (size_t)l * 24 * MiB); }
__device__ __forceinline__ bf16* w_out_t(Frame& F, int l) { return (bf16*)(F.ws + WS_W + (size_t)l * 24 * MiB + 6 * MiB); }
__device__ __forceinline__ bf16* w_up_t(Frame& F, int l) { return (bf16*)(F.ws + WS_W + (size_t)l * 24 * MiB + 8 * MiB); }
__device__ __forceinline__ bf16* w_down_t(Frame& F, int l) { return (bf16*)(F.ws + WS_W + (size_t)l * 24 * MiB + 16 * MiB); }
__device__ __forceinline__ float* st_buf(Frame& F, int l, int which) { return (float*)(F.ws + WS_ST + (size_t)(2 * l + which) * 2 * MiB); }
__device__ __forceinline__ const float* karg(int i) { unsigned off = (unsigned)i * 8u; asm volatile("" : "+s"(off));
    return *(const float* const __attribute__((address_space(4)))*)((const char __attribute__((address_space(4)))*)__builtin_amdgcn_kernarg_segment_ptr() + off); }
struct WPtrs { int dummy; };
enum { KA_X = 0, KA_WIN = 1, KA_SINKS = 2, KA_WOUT = 3, KA_LN1W = 4, KA_LN1B = 5, KA_WUP = 6, KA_WDOWN = 7, KA_LN2W = 8, KA_LN2B = 9 };
constexpr int I_IN = (DM / 64) * (NIN / 32), I_OUT = (DM / 64) * (DM / 32), I_UP = (DM / 64) * (FF / 32), I_DN = (FF / 64) * (DM / 32), PER_L = I_IN + I_OUT + I_UP + I_DN;
__device__ __forceinline__ void weight_item(Frame& F, const WPtrs& W, int l, int r, LAS float* scr, int lane) {
    float* part = (float*)(F.ws + WS_PART);
    if (r < I_IN) { const bool fold = l > 0;
        p0_transpose_item(karg(KA_WIN) + (size_t)l * DM * NIN, DM, NIN, w_in_t(F, l), true, fold ? karg(KA_LN2W) + (l - 1) * DM : nullptr, fold ? karg(KA_LN2B) + (l - 1) * DM : nullptr,
                          fold ? part + PART_IN_CS : nullptr, fold ? part + PART_IN_BB : nullptr, scr, r, lane); return; } r -= I_IN;
    if (r < I_OUT) { p0_transpose_item(karg(KA_WOUT) + (size_t)l * DM * DM, DM, DM, w_out_t(F, l), false, nullptr, nullptr, nullptr, nullptr, scr, r, lane); return; } r -= I_OUT;
    if (r < I_UP) { p0_transpose_item(karg(KA_WUP) + (size_t)l * DM * FF, DM, FF, w_up_t(F, l), false, karg(KA_LN1W) + l * DM, karg(KA_LN1B) + l * DM,
                          part + PART_UP + (size_t)l * 32 * FF, part + PART_UP + (size_t)l * 32 * FF + 16 * FF, scr, r, lane); return; } r -= I_UP;
    p0_transpose_item(karg(KA_WDOWN) + (size_t)l * FF * DM, FF, DM, w_down_t(F, l), false, nullptr, nullptr, nullptr, nullptr, scr, r, lane);
}

__device__ __forceinline__ void p0_prologue(Frame& F, const float* x, const WPtrs& W) {
    LAS float* scr = (LAS float*)(F.lds + RING_OFF + F.wave * 16384);
    const int gw = F.vcu * NWAVES + F.wave, NGW = F.G * NWAVES;
    for (int it = gw; it < PER_L; it += NGW) weight_item(F, W, 0, it, scr, F.lane);
    bf16* XB = (bf16*)(F.ws + WS_XB);
    for (int m = gw; m < M; m += 2 * NGW) {
        const GAS f32x4* xr = (const GAS f32x4*)(x + (size_t)m * DM) + F.lane; GAS unsigned long long* o8 = (GAS unsigned long long*)(XB + (size_t)m * DM) + F.lane;
        const GAS f32x4* xr2 = (const GAS f32x4*)(x + (size_t)(m + NGW) * DM) + F.lane; GAS unsigned long long* o82 = (GAS unsigned long long*)(XB + (size_t)(m + NGW) * DM) + F.lane;
        f32x4 v[8];
#pragma unroll
        for (int j = 0; j < 4; ++j) { v[j] = xr[64 * j]; v[4 + j] = xr2[64 * j]; }
#pragma unroll
        for (int j = 0; j < 4; ++j) o8[64 * j] = (unsigned long long)pk2(v[j].x, v[j].y) | ((unsigned long long)pk2(v[j].z, v[j].w) << 32);
#pragma unroll
        for (int j = 0; j < 4; ++j) o82[64 * j] = (unsigned long long)pk2(v[4 + j].x, v[4 + j].y) | ((unsigned long long)pk2(v[4 + j].z, v[4 + j].w) << 32);
    }
    { float* vec = (float*)(F.ws + WS_VEC); const int gt = F.vcu * (NWAVES * 64) + F.tid;
      if (gt < NIN) { vec[VEC_CSIN + gt] = 0.f; vec[VEC_BBIN + gt] = 0.f; }
      float* nt = (float*)(F.ws + WS_VEC + 128 * 1024);
      if (gt < 192) nt[gt] = ((gt >> 5) & 1) ? 0.f : 1.f;
      else if (gt < 320) { const int q = gt - 192, i = q & 31, which = q >> 5; const double a = (which < 2 ? 16.0 : 80.0) * exp2(-(double)i * (13.287712379549449 / 32.0));
          const double rev = a * 0.15915494309189535; const float fr = (float)(rev - floor(rev)); nt[gt] = (which & 1) ? __builtin_amdgcn_sinf(fr) : __builtin_amdgcn_cosf(fr); } }
    float* cosT = (float*)(F.ws + WS_COS); float* sinT = (float*)(F.ws + WS_SIN);
    for (int idx = F.vcu * (NWAVES * 64) + F.tid; idx < SEQ * 32; idx += F.G * NWAVES * 64) {
        const int pos = idx >> 5, i = idx & 31;
        const float inv = (float)exp2(-(double)i * (13.287712379549449 / 32.0));
        const float ang = (float)pos * inv;
        const double rev = (double)ang * 0.15915494309189535; const float fr = (float)(rev - floor(rev));
        cosT[idx] = __builtin_amdgcn_cosf(fr); sinT[idx] = __builtin_amdgcn_sinf(fr);
    }
}
__device__ __forceinline__ void finalize_vecs(Frame& F, int l) {
    const GAS float* part = (const GAS float*)(F.ws + WS_PART); GAS float* vec = (GAS float*)(F.ws + WS_VEC);
    for (int idx = F.vcu * (NWAVES * 64) + F.tid; idx < NIN + FF; idx += F.G * NWAVES * 64) {
        float cs = 0.f, bs = 0.f;
        if (idx < NIN) { if (l == 0) continue;
#pragma unroll
            for (int kb = 0; kb < 16; ++kb) { cs += part[PART_IN_CS + kb * NIN + idx]; bs += part[PART_IN_BB + kb * NIN + idx]; }
            const int j = (idx & ~0xE0) | ((idx & 0x20) << 2) | ((idx & 0xC0) >> 1);
            vec[VEC_CSIN + l * NIN + j] = cs; vec[VEC_BBIN + l * NIN + j] = bs;
        } else { const int n = idx - NIN; const GAS float* p = part + PART_UP + (size_t)l * 32 * FF;
#pragma unroll
            for (int kb = 0; kb < 16; ++kb) { cs += p[kb * FF + n]; bs += p[16 * FF + kb * FF + n]; }
            vec[VEC_CSUP + l * FF + n] = cs; vec[VEC_BBUP + l * FF + n] = bs; }
    }
}
__device__ __forceinline__ void final_ln(Frame& F, float* out, const bf16* Y, const float* st, const float* w, const float* b) {
    const int gw = F.vcu * NWAVES + F.wave, NGW = F.G * NWAVES;
    f32x4 wv[2][2], bv[2][2];
#pragma unroll
    for (int j = 0; j < 2; ++j)
#pragma unroll
        for (int h = 0; h < 2; ++h) { wv[j][h] = *(const GAS f32x4*)(w + 512 * j + 8 * F.lane + 4 * h); bv[j][h] = *(const GAS f32x4*)(b + 512 * j + 8 * F.lane + 4 * h); }
    for (int m = gw; m < M; m += NGW) {
        float mu, rs; pg8::row_stats(st, m, mu, rs);
#pragma unroll
        for (int j = 0; j < 2; ++j) { const v4u yb = *(const GAS v4u*)(Y + (size_t)m * DM + 512 * j + 8 * F.lane);
            f32x4 r0 = (f32x4){__uint_as_float(yb.x << 16), __uint_as_float(yb.x & 0xffff0000u), __uint_as_float(yb.y << 16), __uint_as_float(yb.y & 0xffff0000u)};
            f32x4 r1 = (f32x4){__uint_as_float(yb.z << 16), __uint_as_float(yb.z & 0xffff0000u), __uint_as_float(yb.w << 16), __uint_as_float(yb.w & 0xffff0000u)};
            r0 = (r0 - mu) * rs * wv[j][0] + bv[j][0]; r1 = (r1 - mu) * rs * wv[j][1] + bv[j][1];
            GAS f32x4* o = (GAS f32x4*)(out + (size_t)m * DM + 512 * j + 8 * F.lane); o[0] = r0; o[1] = r1; }
    }
}
typedef float f32x16 __attribute__((ext_vector_type(16)));
typedef short s16x4 __attribute__((ext_vector_type(4)));
typedef unsigned u32x2m __attribute__((ext_vector_type(2)));
#define MFMA32(a, b, c) __builtin_amdgcn_mfma_f32_32x32x16_bf16((a), (b), (c), 0, 0, 0)
constexpr int COL_AQ = 0, COL_AK = 256, COL_AV = 384, COL_BQ = 512, COL_BK = 768, COL_BV = 1024, COL_CQ = 1280, COL_CK = 1536, COL_CV = 1792, COL_DQ = 2048, COL_DK = 2304, COL_DV = 2560, COL_DG = 2816;
__device__ __forceinline__ int kimg(int row, int ch) { return row * 128 + ((ch ^ ((row >> 1) & 7)) << 4); }
__device__ __forceinline__ int vimg(int row, int ch) { return row * 128 + ((ch ^ (((row >> 1) & 1) << 2)) << 4); }
__device__ __forceinline__ int kperm(int i) { return 16 * ((i >> 2) & 1) + (i & 3) + 4 * (i >> 3); }
__device__ __forceinline__ bf16x8 lds_row8(const LAS unsigned char* p) { return *(const LAS bf16x8*)p; }
__device__ __forceinline__ bf16x8 lds_tr8(const LAS unsigned char* p) {
    typedef short v4s __attribute__((ext_vector_type(4)));
    const v4s lo = __builtin_amdgcn_ds_read_tr16_b64_v4i16((LAS v4s*)p), hi = __builtin_amdgcn_ds_read_tr16_b64_v4i16((LAS v4s*)(p + 512));
    return (bf16x8){lo[0], lo[1], lo[2], lo[3], hi[0], hi[1], hi[2], hi[3]};
}
__device__ __forceinline__ int tr_lane_off(int lane, int rbase, int cb) { const int q = (lane & 15) >> 2, pp = lane & 3, blk = (lane >> 4) & 1; return vimg(rbase + q, 4 * cb + 2 * blk + (pp >> 1)) + 8 * (pp & 1); }
typedef float f32x2_t __attribute__((ext_vector_type(2))); typedef __bf16 bf16x2_t __attribute__((ext_vector_type(2)));
__device__ __forceinline__ unsigned pk_bf16(float lo, float hi) { f32x2_t v = {lo, hi}; bf16x2_t b = __builtin_convertvector(v, bf16x2_t); return __builtin_bit_cast(unsigned, b); }
__device__ __forceinline__ float bf_lo(unsigned u) { return __uint_as_float(u << 16); }
__device__ __forceinline__ float bf_hi(unsigned u) { return __uint_as_float(u & 0xffff0000u); }
__device__ __forceinline__ float xsum32(float v) { auto rr = __builtin_amdgcn_permlane32_swap(__float_as_uint(v), __float_as_uint(v), false, false); return __uint_as_float(rr[0]) + __uint_as_float(rr[1]); }

__device__ __forceinline__ void ret_chain(Frame& F, int b, int h) {
    const bf16* P = (const bf16*)(F.ws + WS_PROJ); bf16* MX = (bf16*)(F.ws + WS_MIXED);
    LAS unsigned char* L = F.lds + RING_OFF;
    constexpr int T_Q = 0, T_K = 16384, T_KW = 32768, T_V = 49152, T_S = 65536;
    const int lane = opaque_lane(), w = F.wave, tid = w * 64 + lane, iq = lane & 31, hi = lane >> 5;
    const float gam = 1.0f - 1.0f / (float)(32 << h); const float lg2 = __builtin_amdgcn_logf(gam);
    for (int i = tid; i < 8192 / 16; i += NWAVES * 64) *(LAS v4u*)(L + T_S + i * 16) = (v4u){0u, 0u, 0u, 0u};
    const size_t rowbase = (size_t)b * SEQ;
    v4u rq[2], rk[2], rv[2]; u32x2m cg[8];
#define RET_LOAD(n) do { _Pragma("unroll") for (int k = 0; k < 2; ++k) { const int p = tid + 512 * k, row = p >> 3, ch = p & 7; const bf16* src = P + (rowbase + (size_t)(n) * 128 + row) * NIN + 64 * h + 8 * ch; \
        rq[k] = *(const GAS v4u*)(src + COL_DQ); rk[k] = *(const GAS v4u*)(src + COL_DK); rv[k] = *(const GAS v4u*)(src + COL_DV); } } while (0)
    RET_LOAD(0);
    f32x16 state;
#pragma unroll
    for (int r = 0; r < 16; ++r) state[r] = 0.f;
    const float g128 = __builtin_amdgcn_exp2f(128.f * lg2);
    float cr[16];
#pragma unroll
    for (int r = 0; r < 16; ++r) cr[r] = __builtin_amdgcn_exp2f(-(float)r * lg2);
    int cur = 0;
    for (int n = 0; n < SEQ / 128; ++n) {
#pragma unroll
        for (int k = 0; k < 2; ++k) { const int p = tid + 512 * k, row = p >> 3, ch = p & 7;
            *(LAS v4u*)(L + T_Q + kimg(row, ch)) = rq[k]; *(LAS v4u*)(L + T_K + kimg(row, ch)) = rk[k]; *(LAS v4u*)(L + T_V + vimg(row, ch)) = rv[k];
            const float f = __builtin_amdgcn_exp2f((float)(127 - row) * lg2); v4u kw;
            kw.x = pk_bf16(bf_lo(rk[k].x) * f, bf_hi(rk[k].x) * f); kw.y = pk_bf16(bf_lo(rk[k].y) * f, bf_hi(rk[k].y) * f); kw.z = pk_bf16(bf_lo(rk[k].z) * f, bf_hi(rk[k].z) * f); kw.w = pk_bf16(bf_lo(rk[k].w) * f, bf_hi(rk[k].w) * f);
            *(LAS v4u*)(L + T_KW + vimg(row, ch)) = kw; }
        { const bf16* gp_ = P + (rowbase + (size_t)n * 128 + 32 * (w & 3) + iq) * NIN + COL_DG + 64 * h + 4 * hi;
#pragma unroll
          for (int e8 = 0; e8 < 8; ++e8) cg[e8] = *(const GAS u32x2m*)(gp_ + 32 * (e8 >> 2) + 8 * (e8 & 3)); }
        if (n + 1 < SEQ / 128) RET_LOAD(n + 1);
        WG_BAR();
        if (w < 4) {
            const int rb = w;
            bf16x8 qf[4];
#pragma unroll
            for (int d0 = 0; d0 < 4; ++d0) qf[d0] = lds_row8(L + T_Q + kimg(32 * rb + iq, 2 * d0 + hi));
            f32x16 cx[2], oa[2];
#pragma unroll
            for (int eb = 0; eb < 2; ++eb) {
#pragma unroll
                for (int r = 0; r < 16; ++r) { cx[eb][r] = 0.f; oa[eb][r] = 0.f; }
#pragma unroll
                for (int d0 = 0; d0 < 4; ++d0) { const bf16x8 sf = lds_tr8(L + T_S + cur * 8192 + tr_lane_off(lane, 16 * d0 + 8 * hi, eb)); cx[eb] = MFMA32(sf, qf[d0], cx[eb]); }
            }
            for (int kb = 0; kb <= rb; ++kb) {
                f32x16 st;
#pragma unroll
                for (int r = 0; r < 16; ++r) st[r] = 0.f;
#pragma unroll
                for (int d0 = 0; d0 < 4; ++d0) { const bf16x8 kf = lds_row8(L + T_K + kimg(32 * kb + kperm(iq), 2 * d0 + hi)); st = MFMA32(kf, qf[d0], st); }
                const float fl = __builtin_amdgcn_exp2f((float)(32 * (rb - kb) + iq - 16 * hi) * lg2);
                const int lim = (kb == rb) ? (iq - 16 * hi) : 64;
                unsigned pw[8];
#pragma unroll
                for (int r = 0; r < 16; r += 2) { const float a = (r <= lim) ? st[r] * cr[r] * fl : 0.f, c = (r + 1 <= lim) ? st[r + 1] * cr[r + 1] * fl : 0.f; pw[r >> 1] = pk_bf16(a, c); }
#pragma unroll
                for (int s = 0; s < 2; ++s) { const bf16x8 pf = __builtin_bit_cast(bf16x8, (v4u){pw[4 * s], pw[4 * s + 1], pw[4 * s + 2], pw[4 * s + 3]});
#pragma unroll
                    for (int eb = 0; eb < 2; ++eb) { const bf16x8 vf = lds_tr8(L + T_V + tr_lane_off(lane, 32 * kb + 16 * hi + 8 * s, eb)); oa[eb] = MFMA32(vf, pf, oa[eb]); } }
            }
            const float cw = __builtin_amdgcn_exp2f((float)(32 * rb + iq + 1) * lg2);
            float s1 = 0.f;
#pragma unroll
            for (int eb = 0; eb < 2; ++eb)
#pragma unroll
                for (int r = 0; r < 16; ++r) { oa[eb][r] += cw * cx[eb][r]; s1 += oa[eb][r]; }
            s1 = xsum32(s1); const float mean = s1 * (1.f / 64.f);
            float s2 = 0.f;
#pragma unroll
            for (int eb = 0; eb < 2; ++eb)
#pragma unroll
                for (int r = 0; r < 16; ++r) { const float d = oa[eb][r] - mean; oa[eb][r] = d; s2 += d * d; }
            s2 = xsum32(s2); const float rstd = __builtin_amdgcn_rsqf(s2 * (1.f / 64.f) + 1e-5f);
            const size_t grow = rowbase + (size_t)n * 128 + 32 * rb + iq;
            bf16* op = MX + grow * DM + 768 + 64 * h;
#pragma unroll
            for (int eb = 0; eb < 2; ++eb)
#pragma unroll
                for (int g4 = 0; g4 < 4; ++g4) { const int e0 = 32 * eb + 8 * g4 + 4 * hi; const u32x2m gg = cg[4 * eb + g4];
                    const float g0 = bf_lo(gg.x), g1 = bf_hi(gg.x), g2 = bf_lo(gg.y), g3 = bf_hi(gg.y);
                    const float y0 = oa[eb][4 * g4 + 0] * rstd * (g0 * __builtin_amdgcn_rcpf(1.f + __expf(-g0))), y1 = oa[eb][4 * g4 + 1] * rstd * (g1 * __builtin_amdgcn_rcpf(1.f + __expf(-g1)));
                    const float y2 = oa[eb][4 * g4 + 2] * rstd * (g2 * __builtin_amdgcn_rcpf(1.f + __expf(-g2))), y3 = oa[eb][4 * g4 + 3] * rstd * (g3 * __builtin_amdgcn_rcpf(1.f + __expf(-g3)));
                    u32x2m o; o.x = pk_bf16(y0, y1); o.y = pk_bf16(y2, y3); *(GAS u32x2m*)(op + e0) = o; }
        } else {
            const int x = w - 4, db = x >> 1, eb = x & 1;
            f32x16 kv;
#pragma unroll
            for (int r = 0; r < 16; ++r) kv[r] = 0.f;
#pragma unroll
            for (int s = 0; s < 8; ++s) { const bf16x8 af = lds_tr8(L + T_KW + tr_lane_off(lane, 16 * s + 8 * hi, db)), bfr = lds_tr8(L + T_V + tr_lane_off(lane, 16 * s + 8 * hi, eb)); kv = MFMA32(af, bfr, kv); }
            const int nxt = cur ^ 1; const int e = iq + 32 * eb;
#pragma unroll
            for (int r = 0; r < 16; ++r) { state[r] = state[r] * g128 + kv[r]; const int d = (r & 3) + 8 * (r >> 2) + 4 * hi + 32 * db;
                *(LAS unsigned short*)(L + T_S + nxt * 8192 + vimg(d, e >> 3) + (e & 7) * 2) = (unsigned short)(pk_bf16(state[r], 0.f) & 0xffffu); }
        }
        WG_BAR();
        cur ^= 1;
    }
#undef RET_LOAD
}

__device__ __forceinline__ void ret_chain2(Frame& F, int b, int hp) {
    const bf16* P = (const bf16*)(F.ws + WS_PROJ); bf16* MX = (bf16*)(F.ws + WS_MIXED);
    const int lane = opaque_lane(), w = F.wave, c = w >> 2, wl = w & 3, tl = wl * 64 + lane, iq = lane & 31, hi = lane >> 5;
    const int h = 2 * hp + c;
    LAS unsigned char* L = F.lds + RING_OFF + c * 65536;
    constexpr int T_K = 0, T_KW = 16384, T_V = 32768, T_S = 49152;
    const float gam = 1.0f - 1.0f / (float)(32 << h); const float lg2 = __builtin_amdgcn_logf(gam);
    for (int i = tl; i < 8192 / 16; i += 256) *(LAS v4u*)(L + T_S + i * 16) = (v4u){0u, 0u, 0u, 0u};
    const size_t rowbase = (size_t)b * SEQ;
    v4u rk[4], rv[4]; u32x2m cg[8]; bf16x8 qf[4];
#define RET2_LOAD(n) do { _Pragma("unroll") for (int k = 0; k < 4; ++k) { const int p = tl + 256 * k, row = p >> 3, ch = p & 7; const bf16* src = P + (rowbase + (size_t)(n) * 128 + row) * NIN + 64 * h + 8 * ch; \
        rk[k] = *(const GAS v4u*)(src + COL_DK); rv[k] = *(const GAS v4u*)(src + COL_DV); } } while (0)
#define RET2_LOADQ(n) do { _Pragma("unroll") for (int d0 = 0; d0 < 4; ++d0) qf[d0] = *(const GAS bf16x8*)(P + (rowbase + (size_t)(n) * 128 + 32 * wl + iq) * NIN + COL_DQ + 64 * h + 16 * d0 + 8 * hi); } while (0)
    RET2_LOAD(0); RET2_LOADQ(0);
    f32x16 state;
#pragma unroll
    for (int r = 0; r < 16; ++r) state[r] = 0.f;
    const float g128 = __builtin_amdgcn_exp2f(128.f * lg2);
    const float ginv = __builtin_amdgcn_exp2f(-lg2);
    int cur = 0;
    for (int n = 0; n < SEQ / 128; ++n) {
#pragma unroll
        for (int k = 0; k < 4; ++k) { const int p = tl + 256 * k, row = p >> 3, ch = p & 7;
            *(LAS v4u*)(L + T_K + kimg(row, ch)) = rk[k]; *(LAS v4u*)(L + T_V + vimg(row, ch)) = rv[k];
            const float f = __builtin_amdgcn_exp2f((float)(127 - row) * lg2); v4u kw;
            kw.x = pk_bf16(bf_lo(rk[k].x) * f, bf_hi(rk[k].x) * f); kw.y = pk_bf16(bf_lo(rk[k].y) * f, bf_hi(rk[k].y) * f); kw.z = pk_bf16(bf_lo(rk[k].z) * f, bf_hi(rk[k].z) * f); kw.w = pk_bf16(bf_lo(rk[k].w) * f, bf_hi(rk[k].w) * f);
            *(LAS v4u*)(L + T_KW + vimg(row, ch)) = kw; }
        if (n + 1 < SEQ / 128) RET2_LOAD(n + 1);
        WG_BAR();
        {
            const int rb = wl;
            f32x16 cx[2], oa[2];
#pragma unroll
            for (int eb = 0; eb < 2; ++eb) {
#pragma unroll
                for (int r = 0; r < 16; ++r) { cx[eb][r] = 0.f; oa[eb][r] = 0.f; }
#pragma unroll
                for (int d0 = 0; d0 < 4; ++d0) { const bf16x8 sf = lds_tr8(L + T_S + cur * 8192 + tr_lane_off(lane, 16 * d0 + 8 * hi, eb)); cx[eb] = MFMA32(sf, qf[d0], cx[eb]); }
            }
            for (int kb = 0; kb <= rb; ++kb) {
                f32x16 st;
#pragma unroll
                for (int r = 0; r < 16; ++r) st[r] = 0.f;
#pragma unroll
                for (int d0 = 0; d0 < 4; ++d0) { const bf16x8 kf = lds_row8(L + T_K + kimg(32 * kb + kperm(iq), 2 * d0 + hi)); st = MFMA32(kf, qf[d0], st); }
                const float fl = __builtin_amdgcn_exp2f((float)(32 * (rb - kb) + iq - 16 * hi) * lg2);
                const int lim = (kb == rb) ? (iq - 16 * hi) : 64;
                unsigned pw[8];
                float fr = fl;
#pragma unroll
                for (int r = 0; r < 16; r += 2) { const float a = (r <= lim) ? st[r] * fr : 0.f; fr *= ginv; const float c2 = (r + 1 <= lim) ? st[r + 1] * fr : 0.f; fr *= ginv; pw[r >> 1] = pk_bf16(a, c2); }
#pragma unroll
                for (int s2 = 0; s2 < 2; ++s2) { const bf16x8 pf = __builtin_bit_cast(bf16x8, (v4u){pw[4 * s2], pw[4 * s2 + 1], pw[4 * s2 + 2], pw[4 * s2 + 3]});
#pragma unroll
                    for (int eb = 0; eb < 2; ++eb) { const bf16x8 vf = lds_tr8(L + T_V + tr_lane_off(lane, 32 * kb + 16 * hi + 8 * s2, eb)); oa[eb] = MFMA32(vf, pf, oa[eb]); } }
            }
            { const bf16* gp_ = P + (rowbase + (size_t)n * 128 + 32 * wl + iq) * NIN + COL_DG + 64 * h + 4 * hi;
#pragma unroll
              for (int e8 = 0; e8 < 8; ++e8) cg[e8] = *(const GAS u32x2m*)(gp_ + 32 * (e8 >> 2) + 8 * (e8 & 3)); }
            if (n + 1 < SEQ / 128) RET2_LOADQ(n + 1);
            const float cw = __builtin_amdgcn_exp2f((float)(32 * rb + iq + 1) * lg2);
            float s1 = 0.f;
#pragma unroll
            for (int eb = 0; eb < 2; ++eb)
#pragma unroll
                for (int r = 0; r < 16; ++r) { oa[eb][r] += cw * cx[eb][r]; s1 += oa[eb][r]; }
            s1 = xsum32(s1); const float mean = s1 * (1.f / 64.f);
            float s2v = 0.f;
#pragma unroll
            for (int eb = 0; eb < 2; ++eb)
#pragma unroll
                for (int r = 0; r < 16; ++r) { const float d = oa[eb][r] - mean; oa[eb][r] = d; s2v += d * d; }
            s2v = xsum32(s2v); const float rstd = __builtin_amdgcn_rsqf(s2v * (1.f / 64.f) + 1e-5f);
            const size_t grow = rowbase + (size_t)n * 128 + 32 * rb + iq;
            bf16* op = MX + grow * DM + 768 + 64 * h;
#pragma unroll
            for (int eb = 0; eb < 2; ++eb)
#pragma unroll
                for (int g4 = 0; g4 < 4; ++g4) { const int e0 = 32 * eb + 8 * g4 + 4 * hi; const u32x2m gg = cg[4 * eb + g4];
                    const float g0 = bf_lo(gg.x), g1 = bf_hi(gg.x), g2 = bf_lo(gg.y), g3 = bf_hi(gg.y);
                    const float y0 = oa[eb][4 * g4 + 0] * rstd * (g0 * __builtin_amdgcn_rcpf(1.f + __expf(-g0))), y1 = oa[eb][4 * g4 + 1] * rstd * (g1 * __builtin_amdgcn_rcpf(1.f + __expf(-g1)));
                    const float y2 = oa[eb][4 * g4 + 2] * rstd * (g2 * __builtin_amdgcn_rcpf(1.f + __expf(-g2))), y3 = oa[eb][4 * g4 + 3] * rstd * (g3 * __builtin_amdgcn_rcpf(1.f + __expf(-g3)));
                    u32x2m o; o.x = pk_bf16(y0, y1); o.y = pk_bf16(y2, y3); *(GAS u32x2m*)(op + e0) = o; }
        }
        {
            const int x = wl, db = x >> 1, eb = x & 1;
            f32x16 kv;
#pragma unroll
            for (int r = 0; r < 16; ++r) kv[r] = 0.f;
#pragma unroll
            for (int s2 = 0; s2 < 8; ++s2) { const bf16x8 af = lds_tr8(L + T_KW + tr_lane_off(lane, 16 * s2 + 8 * hi, db)), bfr = lds_tr8(L + T_V + tr_lane_off(lane, 16 * s2 + 8 * hi, eb)); kv = MFMA32(af, bfr, kv); }
            const int nxt = cur ^ 1; const int e = iq + 32 * eb;
#pragma unroll
            for (int r = 0; r < 16; ++r) { state[r] = state[r] * g128 + kv[r]; const int d = (r & 3) + 8 * (r >> 2) + 4 * hi + 32 * db;
                *(LAS unsigned short*)(L + T_S + nxt * 8192 + vimg(d, e >> 3) + (e & 7) * 2) = (unsigned short)(pk_bf16(state[r], 0.f) & 0xffffu); }
        }
        WG_BAR();
        cur ^= 1;
    }
#undef RET2_LOAD
#undef RET2_LOADQ
}


#define Q_FETCH(lead_) ((lead_) ? __hip_atomic_fetch_add((unsigned*)(F.ctl + CW_Q + 64 * qi), 1u, __ATOMIC_RELAXED, __HIP_MEMORY_SCOPE_AGENT) : 0u)
__device__ __forceinline__ unsigned q_issue(Frame& F, int qi) { unsigned tk, one = 1u; unsigned* p = (unsigned*)(F.ctl + CW_Q + 64 * qi);
    asm volatile("global_atomic_add %0, %1, %2, off sc0" : "=&v"(tk) : "v"(p), "v"(one) : "memory"); return tk; }
#define Q_TAKE(tk_, n_) asm volatile("s_waitcnt vmcnt(" #n_ ")" : "+v"(tk_) :: "memory")
template <int MODE>
__device__ __forceinline__ void attn_unit(Frame& F, int l, const float* sinks, int b, int h, int qb, int qi) {
    const bf16* P = (const bf16*)(F.ws + WS_PROJ); bf16* MX = (bf16*)(F.ws + WS_MIXED);
    LAS unsigned char* L = F.lds + RING_OFF;
    constexpr int SLOT = 16384, VOFF = 8192, FLG = 65536, KMOFF = 69632;
    const int lane = opaque_lane(), w = F.wave, tid = w * 64 + lane, iq = lane & 31, hi = lane >> 5;
    const int qcol = MODE == 0 ? COL_AQ + 64 * h : (MODE == 1 ? COL_BQ + 64 * h : COL_CQ + 64 * h);
    const int kcol = MODE == 0 ? COL_AK + 64 * (h >> 1) : (MODE == 1 ? COL_BK + 64 * h : COL_CK + 64 * h);
    const int vcol = MODE == 0 ? COL_AV + 64 * (h >> 1) : (MODE == 1 ? COL_BV + 64 * h : COL_CV + 64 * h);
    const int ocol = 256 * MODE + 64 * h;
    const size_t rowbase = (size_t)b * SEQ;
    const int q0 = 256 * qb, qw0 = q0 + 32 * w, query = qw0 + iq;
    const int kt_lo = MODE == 0 ? (qb > 0 ? 4 * qb - 2 : 0) : 0, kt_hi = 4 * qb + 4, nt = kt_hi - kt_lo;
    const int drow = 8 * w + (lane >> 3), dch = lane & 7;
    const bf16* ksrc = P + (rowbase + drow) * NIN + kcol + 8 * (dch ^ ((drow >> 1) & 7));
    const bf16* vsrc = P + (rowbase + drow) * NIN + vcol + 8 * (dch ^ (((drow >> 1) & 1) << 2));
#define ATT_KT(it) (MODE == 2 ? kt_hi - 1 - (it) : kt_lo + (it))
#define ATT_DMA(it, slot) do { const size_t o_ = (size_t)ATT_KT(it) * 64 * NIN; \
        __builtin_amdgcn_global_load_lds((const unsigned*)(ksrc + o_), (LAS unsigned*)(L + (slot) * SLOT + w * 1024), 16, 0, 0); \
        __builtin_amdgcn_global_load_lds((const unsigned*)(vsrc + o_), (LAS unsigned*)(L + (slot) * SLOT + VOFF + w * 1024), 16, 0, 0); } while (0)
    bf16x8 qf[4];
#pragma unroll
    for (int d0 = 0; d0 < 4; ++d0) qf[d0] = *(const GAS bf16x8*)(P + (rowbase + query) * NIN + qcol + 16 * d0 + 8 * hi);
    unsigned selmask = 0u;
    if (MODE == 1) {
        if (qb <= 3) selmask = (1u << qb) - 1u;
        else {
            const float* kp = (const float*)(F.ws + WS_KPART);
            for (int idx = tid; idx < qb * 64; idx += NWAVES * 64) { const int j = idx >> 6, d = idx & 63; const GAS float* p0_ = (const GAS float*)kp + (size_t)((b * 16 + j) * 2) * 256 + 64 * h + d;
                *(LAS float*)(L + KMOFF + idx * 4) = p0_[0] + p0_[256]; }
            WG_BAR();
            float qv[32];
#pragma unroll
            for (int d0 = 0; d0 < 4; ++d0)
#pragma unroll
                for (int e = 0; e < 4; ++e) { const unsigned u = __builtin_bit_cast(v4u, qf[d0])[e]; qv[8 * d0 + 2 * e] = bf_lo(u); qv[8 * d0 + 2 * e + 1] = bf_hi(u); }
            float v1 = -INFINITY, v2 = -INFINITY, v3 = -INFINITY; int i1 = 0, i2 = 0, i3 = 0;
            for (int j = 0; j < qb; ++j) {
                float g = 0.f;
#pragma unroll
                for (int d0 = 0; d0 < 4; ++d0) { const f32x4 a = *(const LAS f32x4*)(L + KMOFF + (j * 64 + 16 * d0 + 8 * hi) * 4), c = *(const LAS f32x4*)(L + KMOFF + (j * 64 + 16 * d0 + 8 * hi + 4) * 4);
                    g += qv[8 * d0] * a[0] + qv[8 * d0 + 1] * a[1] + qv[8 * d0 + 2] * a[2] + qv[8 * d0 + 3] * a[3] + qv[8 * d0 + 4] * c[0] + qv[8 * d0 + 5] * c[1] + qv[8 * d0 + 6] * c[2] + qv[8 * d0 + 7] * c[3]; }
                g = xsum32(g);
                if (g > v1) { v3 = v2; i3 = i2; v2 = v1; i2 = i1; v1 = g; i1 = j; } else if (g > v2) { v3 = v2; i3 = i2; v2 = g; i2 = j; } else if (g > v3) { v3 = g; i3 = j; }
            }
            selmask = (1u << i1) | (1u << i2) | (1u << i3);
        }
    }
    if (MODE == 2 && lane == 0) *(LAS unsigned*)(L + FLG + 4 * w) = 0u;
    float m_ref = -INFINITY, l_run = 0.f, carry = 0.f; bool done = false;
    if (MODE == 0) { m_ref = ((const GAS float*)sinks)[l * 4 + h] * 1.4426950408889634f; l_run = hi ? 0.f : 1.f; }
    f32x16 o[2];
#pragma unroll
    for (int r = 0; r < 16; ++r) { o[0][r] = 0.f; o[1][r] = 0.f; }
    asm volatile("s_waitcnt vmcnt(0)" ::: "memory");
    int koff[4];
#pragma unroll
    for (int d0 = 0; d0 < 4; ++d0) koff[d0] = kimg(kperm(iq), 2 * d0 + hi);
    const int voff0 = VOFF + tr_lane_off(lane, 16 * hi, 0), voff1 = VOFF + tr_lane_off(lane, 16 * hi, 1);
#define ATT_QK(PA, PB, sl) do { const LAS unsigned char* Kb_ = L + (sl) * SLOT; bf16x8 kf_[8]; \
        _Pragma("unroll") for (int d0 = 0; d0 < 4; ++d0) { kf_[2 * d0] = lds_row8(Kb_ + koff[d0]); kf_[2 * d0 + 1] = lds_row8(Kb_ + koff[d0] + 4096); } \
        asm volatile("" : "+v"(kf_[0]), "+v"(kf_[1]), "+v"(kf_[2]), "+v"(kf_[3]), "+v"(kf_[4]), "+v"(kf_[5]), "+v"(kf_[6]), "+v"(kf_[7]));     \
        _Pragma("unroll") for (int r = 0; r < 16; ++r) { PA[r] = 0.f; PB[r] = 0.f; } \
        _Pragma("unroll") for (int d0 = 0; d0 < 4; ++d0) { PA = MFMA32(kf_[2 * d0], qf[d0], PA); PB = MFMA32(kf_[2 * d0 + 1], qf[d0], PB); } } while (0)
#define ATT_REL(it_) (MODE == 0 ? ((64 * ATT_KT(it_) + 63 >= qw0 - 127) && (64 * ATT_KT(it_) <= qw0 + 31)) : \
                      MODE == 1 ? (((ATT_KT(it_) >> 2) == qb) ? (64 * ATT_KT(it_) <= qw0 + 31) : (__ballot((selmask >> (ATT_KT(it_) >> 2)) & 1u) != 0ull)) : ((64 * ATT_KT(it_) <= qw0 + 30) && !done))
    ATT_DMA(0, 0);
    if (nt > 1) ATT_DMA(1, 1);
    if (nt > 2) ATT_DMA(2, 2);
    if (nt > 2) asm volatile("s_waitcnt vmcnt(4)" ::: "memory"); else if (nt > 1) asm volatile("s_waitcnt vmcnt(2)" ::: "memory"); else asm volatile("s_waitcnt vmcnt(0)" ::: "memory");
    constexpr bool PIPE = (MODE == 1);
    f32x16 p0, p1, n0, n1;
    if (PIPE) { WG_BAR(); ATT_QK(p0, p1, 0); }
    bool rel_cur = ATT_REL(0);
    for (int it = 0;;) {
        {
        if (PIPE) { if (it + 2 < nt) asm volatile("s_waitcnt vmcnt(2)" ::: "memory"); else asm volatile("s_waitcnt vmcnt(0)" ::: "memory"); }
        else if (it > 0) { if (it + 2 < nt) asm volatile("s_waitcnt vmcnt(4)" ::: "memory"); else if (it + 1 < nt) asm volatile("s_waitcnt vmcnt(2)" ::: "memory"); else asm volatile("s_waitcnt vmcnt(0)" ::: "memory"); }
        WG_BAR();
        if (MODE == 2) { const v4u f0 = *(const LAS v4u*)(L + FLG), f1 = *(const LAS v4u*)(L + FLG + 16); if ((f0.x & f0.y & f0.z & f0.w & f1.x & f1.y & f1.z & f1.w) != 0u) break; }
        if (it + 3 < nt) ATT_DMA(it + 3, (it + 3) & 3);
        const int kt = ATT_KT(it), slot = it & 3, nslot = (it + 1) & 3;
        if (rel_cur) {
            const LAS unsigned char* Vb = L + slot * SLOT;
            if (PIPE) ATT_QK(n0, n1, nslot);
            else ATT_QK(p0, p1, slot);
            constexpr bool EARLYV = (MODE != 2);
            s16x4 vr[16];
            if (EARLYV) { const unsigned va0 = (unsigned)(uintptr_t)(Vb + voff0), va1 = (unsigned)(uintptr_t)(Vb + voff1);
#define TRR(i, o_) "ds_read_b64_tr_b16 %" #i ", %16 offset:" #o_ "\n\tds_read_b64_tr_b16 %" #i "+1, %16 offset:" #o_ "+512\n\t"
              asm volatile("ds_read_b64_tr_b16 %0, %16 offset:0\n\tds_read_b64_tr_b16 %1, %16 offset:512\n\tds_read_b64_tr_b16 %2, %17 offset:0\n\tds_read_b64_tr_b16 %3, %17 offset:512\n\t"
                           "ds_read_b64_tr_b16 %4, %16 offset:1024\n\tds_read_b64_tr_b16 %5, %16 offset:1536\n\tds_read_b64_tr_b16 %6, %17 offset:1024\n\tds_read_b64_tr_b16 %7, %17 offset:1536\n\t"
                           "ds_read_b64_tr_b16 %8, %16 offset:4096\n\tds_read_b64_tr_b16 %9, %16 offset:4608\n\tds_read_b64_tr_b16 %10, %17 offset:4096\n\tds_read_b64_tr_b16 %11, %17 offset:4608\n\t"
                           "ds_read_b64_tr_b16 %12, %16 offset:5120\n\tds_read_b64_tr_b16 %13, %16 offset:5632\n\tds_read_b64_tr_b16 %14, %17 offset:5120\n\tds_read_b64_tr_b16 %15, %17 offset:5632"
                           : "=&v"(vr[0]), "=&v"(vr[1]), "=&v"(vr[2]), "=&v"(vr[3]), "=&v"(vr[4]), "=&v"(vr[5]), "=&v"(vr[6]), "=&v"(vr[7]), "=&v"(vr[8]), "=&v"(vr[9]), "=&v"(vr[10]), "=&v"(vr[11]), "=&v"(vr[12]), "=&v"(vr[13]), "=&v"(vr[14]), "=&v"(vr[15])
                           : "v"(va0), "v"(va1) : "memory");
#undef TRR
            }
            const int key0 = 64 * kt + 16 * hi;
            unsigned pw[16];
            if (MODE != 2) {
                bool lane_on = true;
                if (MODE == 0) {
                    if (64 * kt + 63 > qw0 || 64 * kt < qw0 + 31 - 127) {
#pragma unroll
                        for (int r = 0; r < 16; ++r) { const int ka = key0 + r, kb2 = key0 + 32 + r; if (!(ka <= query && query - ka < 128)) p0[r] = -INFINITY; if (!(kb2 <= query && query - kb2 < 128)) p1[r] = -INFINITY; }
                    }
                } else {
                    if ((kt >> 2) == qb) {
                        if (64 * kt + 63 > qw0) {
#pragma unroll
                            for (int r = 0; r < 16; ++r) { if (key0 + r > query) p0[r] = -INFINITY; if (key0 + 32 + r > query) p1[r] = -INFINITY; }
                        }
                    } else lane_on = (selmask >> (kt >> 2)) & 1u;
                }
#define MX3(a, b, c) __builtin_fmaxf(__builtin_fmaxf((a), (b)), (c))
                float tma = MX3(p0[0], p0[1], p1[0]), tmb = MX3(p0[2], p0[3], p1[1]); tma = MX3(tma, p1[2], p1[3]);
#pragma unroll
                for (int r = 4; r < 16; r += 4) { tma = MX3(tma, p0[r], p0[r + 1]); tmb = MX3(tmb, p0[r + 2], p0[r + 3]); tma = MX3(tma, p1[r], p1[r + 1]); tmb = MX3(tmb, p1[r + 2], p1[r + 3]); }
                float tm = __builtin_fmaxf(tma, tmb);
                { auto rr = __builtin_amdgcn_permlane32_swap(__float_as_uint(tm), __float_as_uint(tm), false, false); tm = __builtin_fmaxf(__uint_as_float(rr[0]), __uint_as_float(rr[1])); }
#undef MX3
                if (!lane_on) tm = -INFINITY;
                if (__any(tm > m_ref + 8.0f)) {
                    const float mnew = (tm > m_ref + 8.0f) ? tm : m_ref;
                    const float sc = (mnew == m_ref) ? 1.f : __builtin_amdgcn_exp2f(m_ref - mnew);
                    l_run *= sc;
#pragma unroll
                    for (int r = 0; r < 16; ++r) { o[0][r] *= sc; o[1][r] *= sc; }
                    m_ref = mnew;
                }
                const float msub = lane_on ? ((m_ref == -INFINITY) ? 0.f : m_ref) : INFINITY;
                f32x2_t ls2 = {0.f, 0.f}; const f32x2_t ms2 = {msub, msub};
#pragma unroll
                for (int r = 0; r < 16; r += 2) { f32x2_t a = (f32x2_t){p0[r], p0[r + 1]} - ms2, c = (f32x2_t){p1[r], p1[r + 1]} - ms2;
                    a.x = __builtin_amdgcn_exp2f(a.x); a.y = __builtin_amdgcn_exp2f(a.y); c.x = __builtin_amdgcn_exp2f(c.x); c.y = __builtin_amdgcn_exp2f(c.y);
                    p0[r] = a.x; p0[r + 1] = a.y; p1[r] = c.x; p1[r + 1] = c.y; ls2 += a; ls2 += c; }
                l_run += ls2.x + ls2.y;
            } else {
                float t0 = 0.f, t1 = 0.f;
                if (64 * kt + 63 >= qw0) {
#pragma unroll
                    for (int r = 15; r >= 0; --r) {
                        { const float z = p0[r]; const bool v = key0 + r < query; const float sp = fmaxf(z, 0.f) + __builtin_amdgcn_logf(1.f + __builtin_amdgcn_exp2f(-fabsf(z))); t0 += v ? -sp : 0.f; p0[r] = v ? z + t0 : -INFINITY; }
                        { const float z = p1[r]; const bool v = key0 + 32 + r < query; const float sp = fmaxf(z, 0.f) + __builtin_amdgcn_logf(1.f + __builtin_amdgcn_exp2f(-fabsf(z))); t1 += v ? -sp : 0.f; p1[r] = v ? z + t1 : -INFINITY; }
                    }
                } else {
#pragma unroll
                    for (int r = 15; r >= 0; --r) {
                        { const float z = p0[r]; const float sp = fmaxf(z, 0.f) + __builtin_amdgcn_logf(1.f + __builtin_amdgcn_exp2f(-fabsf(z))); t0 -= sp; p0[r] = z + t0; }
                        { const float z = p1[r]; const float sp = fmaxf(z, 0.f) + __builtin_amdgcn_logf(1.f + __builtin_amdgcn_exp2f(-fabsf(z))); t1 -= sp; p1[r] = z + t1; }
                    }
                }
                float x0, x1;
                { auto rr = __builtin_amdgcn_permlane32_swap(__float_as_uint(t0), __float_as_uint(t0), false, false); x0 = hi ? __uint_as_float(rr[0]) : __uint_as_float(rr[1]); }
                { auto rr = __builtin_amdgcn_permlane32_swap(__float_as_uint(t1), __float_as_uint(t1), false, false); x1 = hi ? __uint_as_float(rr[0]) : __uint_as_float(rr[1]); }
                const float after1 = carry + (hi ? 0.f : x1), after0 = carry + t1 + x1 + (hi ? 0.f : x0);
#pragma unroll
                for (int r = 0; r < 16; ++r) { p0[r] = __builtin_amdgcn_exp2f(p0[r] + after0); p1[r] = __builtin_amdgcn_exp2f(p1[r] + after1); }
                carry += (t0 + t1) + (x0 + x1);
                done = __all(carry < -151.0f) != 0;
            }
#pragma unroll
            for (int r = 0; r < 16; r += 2) { pw[r >> 1] = pk_bf16(p0[r], p0[r + 1]); pw[8 + (r >> 1)] = pk_bf16(p1[r], p1[r + 1]); }
            if (EARLYV) {
            asm volatile("s_waitcnt lgkmcnt(0)" : "+v"(vr[0]), "+v"(vr[1]), "+v"(vr[2]), "+v"(vr[3]), "+v"(vr[4]), "+v"(vr[5]), "+v"(vr[6]), "+v"(vr[7]), "+v"(vr[8]), "+v"(vr[9]), "+v"(vr[10]), "+v"(vr[11]), "+v"(vr[12]), "+v"(vr[13]), "+v"(vr[14]), "+v"(vr[15]) :: "memory");
#pragma unroll
            for (int ps = 0; ps < 4; ++ps) { const bf16x8 pf = __builtin_bit_cast(bf16x8, (v4u){pw[4 * ps], pw[4 * ps + 1], pw[4 * ps + 2], pw[4 * ps + 3]});
                const bf16x8 vf0 = (bf16x8){vr[4 * ps][0], vr[4 * ps][1], vr[4 * ps][2], vr[4 * ps][3], vr[4 * ps + 1][0], vr[4 * ps + 1][1], vr[4 * ps + 1][2], vr[4 * ps + 1][3]};
                const bf16x8 vf1 = (bf16x8){vr[4 * ps + 2][0], vr[4 * ps + 2][1], vr[4 * ps + 2][2], vr[4 * ps + 2][3], vr[4 * ps + 3][0], vr[4 * ps + 3][1], vr[4 * ps + 3][2], vr[4 * ps + 3][3]};
                o[0] = MFMA32(vf0, pf, o[0]); o[1] = MFMA32(vf1, pf, o[1]); }
            } else {
            const unsigned va0 = (unsigned)(uintptr_t)(Vb + voff0), va1 = (unsigned)(uintptr_t)(Vb + voff1);
#pragma unroll
            for (int ps = 0; ps < 4; ++ps) { const bf16x8 pf = __builtin_bit_cast(bf16x8, (v4u){pw[4 * ps], pw[4 * ps + 1], pw[4 * ps + 2], pw[4 * ps + 3]});
                s16x4 a0, a1, b0, b1;
                asm volatile("ds_read_b64_tr_b16 %0, %4 offset:%c6\n\tds_read_b64_tr_b16 %1, %4 offset:%c7\n\tds_read_b64_tr_b16 %2, %5 offset:%c6\n\tds_read_b64_tr_b16 %3, %5 offset:%c7\n\ts_waitcnt lgkmcnt(0)"
                             : "=&v"(a0), "=&v"(a1), "=&v"(b0), "=&v"(b1) : "v"(va0), "v"(va1), "i"((32 * (ps >> 1) + 8 * (ps & 1)) * 128), "i"((32 * (ps >> 1) + 8 * (ps & 1)) * 128 + 512) : "memory");
                const bf16x8 vf0 = (bf16x8){a0[0], a0[1], a0[2], a0[3], a1[0], a1[1], a1[2], a1[3]}, vf1 = (bf16x8){b0[0], b0[1], b0[2], b0[3], b1[0], b1[1], b1[2], b1[3]};
                o[0] = MFMA32(vf0, pf, o[0]); o[1] = MFMA32(vf1, pf, o[1]); }
            }
        } else {
            if (PIPE) ATT_QK(n0, n1, nslot);
        }
        if (MODE == 2) { if (lane == 0) *(LAS unsigned*)(L + FLG + 4 * w) = (done || kt == 0) ? 1u : 0u; }
        rel_cur = (it + 1 < nt) ? ATT_REL(it + 1) : false;
            }
        ++it; if (it >= nt) break;
        {
        if (PIPE) { if (it + 2 < nt) asm volatile("s_waitcnt vmcnt(2)" ::: "memory"); else asm volatile("s_waitcnt vmcnt(0)" ::: "memory"); }
        else if (it > 0) { if (it + 2 < nt) asm volatile("s_waitcnt vmcnt(4)" ::: "memory"); else if (it + 1 < nt) asm volatile("s_waitcnt vmcnt(2)" ::: "memory"); else asm volatile("s_waitcnt vmcnt(0)" ::: "memory"); }
        WG_BAR();
        if (MODE == 2) { const v4u f0 = *(const LAS v4u*)(L + FLG), f1 = *(const LAS v4u*)(L + FLG + 16); if ((f0.x & f0.y & f0.z & f0.w & f1.x & f1.y & f1.z & f1.w) != 0u) break; }
        if (it + 3 < nt) ATT_DMA(it + 3, (it + 3) & 3);
        const int kt = ATT_KT(it), slot = it & 3, nslot = (it + 1) & 3;
        if (rel_cur) {
            const LAS unsigned char* Vb = L + slot * SLOT;
            if (PIPE) ATT_QK(p0, p1, nslot);
            else ATT_QK(n0, n1, slot);
            constexpr bool EARLYV = (MODE != 2);
            s16x4 vr[16];
            if (EARLYV) { const unsigned va0 = (unsigned)(uintptr_t)(Vb + voff0), va1 = (unsigned)(uintptr_t)(Vb + voff1);
#define TRR(i, o_) "ds_read_b64_tr_b16 %" #i ", %16 offset:" #o_ "\n\tds_read_b64_tr_b16 %" #i "+1, %16 offset:" #o_ "+512\n\t"
              asm volatile("ds_read_b64_tr_b16 %0, %16 offset:0\n\tds_read_b64_tr_b16 %1, %16 offset:512\n\tds_read_b64_tr_b16 %2, %17 offset:0\n\tds_read_b64_tr_b16 %3, %17 offset:512\n\t"
                           "ds_read_b64_tr_b16 %4, %16 offset:1024\n\tds_read_b64_tr_b16 %5, %16 offset:1536\n\tds_read_b64_tr_b16 %6, %17 offset:1024\n\tds_read_b64_tr_b16 %7, %17 offset:1536\n\t"
                           "ds_read_b64_tr_b16 %8, %16 offset:4096\n\tds_read_b64_tr_b16 %9, %16 offset:4608\n\tds_read_b64_tr_b16 %10, %17 offset:4096\n\tds_read_b64_tr_b16 %11, %17 offset:4608\n\t"
                           "ds_read_b64_tr_b16 %12, %16 offset:5120\n\tds_read_b64_tr_b16 %13, %16 offset:5632\n\tds_read_b64_tr_b16 %14, %17 offset:5120\n\tds_read_b64_tr_b16 %15, %17 offset:5632"
                           : "=&v"(vr[0]), "=&v"(vr[1]), "=&v"(vr[2]), "=&v"(vr[3]), "=&v"(vr[4]), "=&v"(vr[5]), "=&v"(vr[6]), "=&v"(vr[7]), "=&v"(vr[8]), "=&v"(vr[9]), "=&v"(vr[10]), "=&v"(vr[11]), "=&v"(vr[12]), "=&v"(vr[13]), "=&v"(vr[14]), "=&v"(vr[15])
                           : "v"(va0), "v"(va1) : "memory");
#undef TRR
            }
            const int key0 = 64 * kt + 16 * hi;
            unsigned pw[16];
            if (MODE != 2) {
                bool lane_on = true;
                if (MODE == 0) {
                    if (64 * kt + 63 > qw0 || 64 * kt < qw0 + 31 - 127) {
#pragma unroll
                        for (int r = 0; r < 16; ++r) { const int ka = key0 + r, kb2 = key0 + 32 + r; if (!(ka <= query && query - ka < 128)) n0[r] = -INFINITY; if (!(kb2 <= query && query - kb2 < 128)) n1[r] = -INFINITY; }
                    }
                } else {
                    if ((kt >> 2) == qb) {
                        if (64 * kt + 63 > qw0) {
#pragma unroll
                            for (int r = 0; r < 16; ++r) { if (key0 + r > query) n0[r] = -INFINITY; if (key0 + 32 + r > query) n1[r] = -INFINITY; }
                        }
                    } else lane_on = (selmask >> (kt >> 2)) & 1u;
                }
#define MX3(a, b, c) __builtin_fmaxf(__builtin_fmaxf((a), (b)), (c))
                float tma = MX3(n0[0], n0[1], n1[0]), tmb = MX3(n0[2], n0[3], n1[1]); tma = MX3(tma, n1[2], n1[3]);
#pragma unroll
                for (int r = 4; r < 16; r += 4) { tma = MX3(tma, n0[r], n0[r + 1]); tmb = MX3(tmb, n0[r + 2], n0[r + 3]); tma = MX3(tma, n1[r], n1[r + 1]); tmb = MX3(tmb, n1[r + 2], n1[r + 3]); }
                float tm = __builtin_fmaxf(tma, tmb);
                { auto rr = __builtin_amdgcn_permlane32_swap(__float_as_uint(tm), __float_as_uint(tm), false, false); tm = __builtin_fmaxf(__uint_as_float(rr[0]), __uint_as_float(rr[1])); }
#undef MX3
                if (!lane_on) tm = -INFINITY;
                if (__any(tm > m_ref + 8.0f)) {
                    const float mnew = (tm > m_ref + 8.0f) ? tm : m_ref;
                    const float sc = (mnew == m_ref) ? 1.f : __builtin_amdgcn_exp2f(m_ref - mnew);
                    l_run *= sc;
#pragma unroll
                    for (int r = 0; r < 16; ++r) { o[0][r] *= sc; o[1][r] *= sc; }
                    m_ref = mnew;
                }
                const float msub = lane_on ? ((m_ref == -INFINITY) ? 0.f : m_ref) : INFINITY;
                f32x2_t ls2 = {0.f, 0.f}; const f32x2_t ms2 = {msub, msub};
#pragma unroll
                for (int r = 0; r < 16; r += 2) { f32x2_t a = (f32x2_t){n0[r], n0[r + 1]} - ms2, c = (f32x2_t){n1[r], n1[r + 1]} - ms2;
                    a.x = __builtin_amdgcn_exp2f(a.x); a.y = __builtin_amdgcn_exp2f(a.y); c.x = __builtin_amdgcn_exp2f(c.x); c.y = __builtin_amdgcn_exp2f(c.y);
                    n0[r] = a.x; n0[r + 1] = a.y; n1[r] = c.x; n1[r + 1] = c.y; ls2 += a; ls2 += c; }
                l_run += ls2.x + ls2.y;
            } else {
                float t0 = 0.f, t1 = 0.f;
                if (64 * kt + 63 >= qw0) {
#pragma unroll
                    for (int r = 15; r >= 0; --r) {
                        { const float z = n0[r]; const bool v = key0 + r < query; const float sp = fmaxf(z, 0.f) + __builtin_amdgcn_logf(1.f + __builtin_amdgcn_exp2f(-fabsf(z))); t0 += v ? -sp : 0.f; n0[r] = v ? z + t0 : -INFINITY; }
                        { const float z = n1[r]; const bool v = key0 + 32 + r < query; const float sp = fmaxf(z, 0.f) + __builtin_amdgcn_logf(1.f + __builtin_amdgcn_exp2f(-fabsf(z))); t1 += v ? -sp : 0.f; n1[r] = v ? z + t1 : -INFINITY; }
                    }
                } else {
#pragma unroll
                    for (int r = 15; r >= 0; --r) {
                        { const float z = n0[r]; const float sp = fmaxf(z, 0.f) + __builtin_amdgcn_logf(1.f + __builtin_amdgcn_exp2f(-fabsf(z))); t0 -= sp; n0[r] = z + t0; }
                        { const float z = n1[r]; const float sp = fmaxf(z, 0.f) + __builtin_amdgcn_logf(1.f + __builtin_amdgcn_exp2f(-fabsf(z))); t1 -= sp; n1[r] = z + t1; }
                    }
                }
                float x0, x1;
                { auto rr = __builtin_amdgcn_permlane32_swap(__float_as_uint(t0), __float_as_uint(t0), false, false); x0 = hi ? __uint_as_float(rr[0]) : __uint_as_float(rr[1]); }
                { auto rr = __builtin_amdgcn_permlane32_swap(__float_as_uint(t1), __float_as_uint(t1), false, false); x1 = hi ? __uint_as_float(rr[0]) : __uint_as_float(rr[1]); }
                const float after1 = carry + (hi ? 0.f : x1), after0 = carry + t1 + x1 + (hi ? 0.f : x0);
#pragma unroll
                for (int r = 0; r < 16; ++r) { n0[r] = __builtin_amdgcn_exp2f(n0[r] + after0); n1[r] = __builtin_amdgcn_exp2f(n1[r] + after1); }
                carry += (t0 + t1) + (x0 + x1);
                done = __all(carry < -151.0f) != 0;
            }
#pragma unroll
            for (int r = 0; r < 16; r += 2) { pw[r >> 1] = pk_bf16(n0[r], n0[r + 1]); pw[8 + (r >> 1)] = pk_bf16(n1[r], n1[r + 1]); }
            if (EARLYV) {
            asm volatile("s_waitcnt lgkmcnt(0)" : "+v"(vr[0]), "+v"(vr[1]), "+v"(vr[2]), "+v"(vr[3]), "+v"(vr[4]), "+v"(vr[5]), "+v"(vr[6]), "+v"(vr[7]), "+v"(vr[8]), "+v"(vr[9]), "+v"(vr[10]), "+v"(vr[11]), "+v"(vr[12]), "+v"(vr[13]), "+v"(vr[14]), "+v"(vr[15]) :: "memory");
#pragma unroll
            for (int ps = 0; ps < 4; ++ps) { const bf16x8 pf = __builtin_bit_cast(bf16x8, (v4u){pw[4 * ps], pw[4 * ps + 1], pw[4 * ps + 2], pw[4 * ps + 3]});
                const bf16x8 vf0 = (bf16x8){vr[4 * ps][0], vr[4 * ps][1], vr[4 * ps][2], vr[4 * ps][3], vr[4 * ps + 1][0], vr[4 * ps + 1][1], vr[4 * ps + 1][2], vr[4 * ps + 1][3]};
                const bf16x8 vf1 = (bf16x8){vr[4 * ps + 2][0], vr[4 * ps + 2][1], vr[4 * ps + 2][2], vr[4 * ps + 2][3], vr[4 * ps + 3][0], vr[4 * ps + 3][1], vr[4 * ps + 3][2], vr[4 * ps + 3][3]};
                o[0] = MFMA32(vf0, pf, o[0]); o[1] = MFMA32(vf1, pf, o[1]); }
            } else {
            const unsigned va0 = (unsigned)(uintptr_t)(Vb + voff0), va1 = (unsigned)(uintptr_t)(Vb + voff1);
#pragma unroll
            for (int ps = 0; ps < 4; ++ps) { const bf16x8 pf = __builtin_bit_cast(bf16x8, (v4u){pw[4 * ps], pw[4 * ps + 1], pw[4 * ps + 2], pw[4 * ps + 3]});
                s16x4 a0, a1, b0, b1;
                asm volatile("ds_read_b64_tr_b16 %0, %4 offset:%c6\n\tds_read_b64_tr_b16 %1, %4 offset:%c7\n\tds_read_b64_tr_b16 %2, %5 offset:%c6\n\tds_read_b64_tr_b16 %3, %5 offset:%c7\n\ts_waitcnt lgkmcnt(0)"
                             : "=&v"(a0), "=&v"(a1), "=&v"(b0), "=&v"(b1) : "v"(va0), "v"(va1), "i"((32 * (ps >> 1) + 8 * (ps & 1)) * 128), "i"((32 * (ps >> 1) + 8 * (ps & 1)) * 128 + 512) : "memory");
                const bf16x8 vf0 = (bf16x8){a0[0], a0[1], a0[2], a0[3], a1[0], a1[1], a1[2], a1[3]}, vf1 = (bf16x8){b0[0], b0[1], b0[2], b0[3], b1[0], b1[1], b1[2], b1[3]};
                o[0] = MFMA32(vf0, pf, o[0]); o[1] = MFMA32(vf1, pf, o[1]); }
            }
        } else {
            if (PIPE) ATT_QK(p0, p1, nslot);
        }
        if (MODE == 2) { if (lane == 0) *(LAS unsigned*)(L + FLG + 4 * w) = (done || kt == 0) ? 1u : 0u; }
        rel_cur = (it + 1 < nt) ? ATT_REL(it + 1) : false;
            }
        ++it; if (it >= nt) break;
    }
#undef ATT_QK
#undef ATT_REL
    asm volatile("s_waitcnt vmcnt(0)" ::: "memory");
    float inv = 1.f;
    if (MODE != 2) { const float lt = xsum32(l_run); inv = 1.0f / lt; }
#ifdef PROBE_ZERO_MODE
    if (MODE == PROBE_ZERO_MODE) inv = 0.f;
#endif
    const int lane_e = opaque_lane(), hi_e = lane_e >> 5;
    const bool qlead = (w == 0 && lane_e == 0); unsigned tk = 0u; if (qlead) tk = q_issue(F, qi);
    bf16* op = MX + ((size_t)b * SEQ + q0 + 32 * w + (lane_e & 31)) * DM + ocol + 4 * hi_e;
#pragma unroll
    for (int eb = 0; eb < 2; ++eb)
#pragma unroll
        for (int g4 = 0; g4 < 4; ++g4) { u32x2m ov; ov.x = pk_bf16(o[eb][4 * g4] * inv, o[eb][4 * g4 + 1] * inv); ov.y = pk_bf16(o[eb][4 * g4 + 2] * inv, o[eb][4 * g4 + 3] * inv);
            *(GAS u32x2m*)(op + 32 * eb + 8 * g4) = ov; }
    if (qlead) { Q_TAKE(tk, 8); F.MISC[0] = tk; }
    WG_BAR();
#undef ATT_KT
#undef ATT_DMA
}

template <int MODE>
__device__ __forceinline__ void wave_tile(const LAS unsigned char* Kb, const bf16x8 (&qf)[4], const int (&koff)[4], int voff0, int voff1, int kt, int qw0, int query, int hi,
                                          f32x16 (&o)[2], float& m_ref, float& l_run, float& carry, bool& done, const bool diag = false) {
    f32x16 p0, p1;
    { bf16x8 kf_[8];
#pragma unroll
      for (int d0 = 0; d0 < 4; ++d0) { kf_[2 * d0] = lds_row8(Kb + koff[d0]); kf_[2 * d0 + 1] = lds_row8(Kb + koff[d0] + 4096); }
      asm volatile("" : "+v"(kf_[0]), "+v"(kf_[1]), "+v"(kf_[2]), "+v"(kf_[3]), "+v"(kf_[4]), "+v"(kf_[5]), "+v"(kf_[6]), "+v"(kf_[7]));
#pragma unroll
      for (int r = 0; r < 16; ++r) { p0[r] = 0.f; p1[r] = 0.f; }
#pragma unroll
      for (int d0 = 0; d0 < 4; ++d0) { p0 = MFMA32(kf_[2 * d0], qf[d0], p0); p1 = MFMA32(kf_[2 * d0 + 1], qf[d0], p1); } }
    s16x4 vr[16];
    { const unsigned va0 = (unsigned)(uintptr_t)(Kb + voff0), va1 = (unsigned)(uintptr_t)(Kb + voff1);
      asm volatile("ds_read_b64_tr_b16 %0, %16 offset:0\n\tds_read_b64_tr_b16 %1, %16 offset:512\n\tds_read_b64_tr_b16 %2, %17 offset:0\n\tds_read_b64_tr_b16 %3, %17 offset:512\n\t"
                   "ds_read_b64_tr_b16 %4, %16 offset:1024\n\tds_read_b64_tr_b16 %5, %16 offset:1536\n\tds_read_b64_tr_b16 %6, %17 offset:1024\n\tds_read_b64_tr_b16 %7, %17 offset:1536\n\t"
                   "ds_read_b64_tr_b16 %8, %16 offset:4096\n\tds_read_b64_tr_b16 %9, %16 offset:4608\n\tds_read_b64_tr_b16 %10, %17 offset:4096\n\tds_read_b64_tr_b16 %11, %17 offset:4608\n\t"
                   "ds_read_b64_tr_b16 %12, %16 offset:5120\n\tds_read_b64_tr_b16 %13, %16 offset:5632\n\tds_read_b64_tr_b16 %14, %17 offset:5120\n\tds_read_b64_tr_b16 %15, %17 offset:5632"
                   : "=&v"(vr[0]), "=&v"(vr[1]), "=&v"(vr[2]), "=&v"(vr[3]), "=&v"(vr[4]), "=&v"(vr[5]), "=&v"(vr[6]), "=&v"(vr[7]), "=&v"(vr[8]), "=&v"(vr[9]), "=&v"(vr[10]), "=&v"(vr[11]), "=&v"(vr[12]), "=&v"(vr[13]), "=&v"(vr[14]), "=&v"(vr[15])
                   : "v"(va0), "v"(va1) : "memory"); }
    const int key0 = 64 * kt + 16 * hi;
    if (MODE == 0 || MODE == 1) {
        if (MODE == 0) {
        if (64 * kt + 63 > qw0 || 64 * kt < qw0 + 31 - 127) {
#pragma unroll
            for (int r = 0; r < 16; ++r) { const int ka = key0 + r, kb2 = key0 + 32 + r; if (!(ka <= query && query - ka < 128)) p0[r] = -INFINITY; if (!(kb2 <= query && query - kb2 < 128)) p1[r] = -INFINITY; }
        }
        } else if (diag) {
#pragma unroll
            for (int r = 0; r < 16; ++r) { if (key0 + r > query) p0[r] = -INFINITY; if (key0 + 32 + r > query) p1[r] = -INFINITY; }
        }
#define MX3(a, b, c) __builtin_fmaxf(__builtin_fmaxf((a), (b)), (c))
        float tma = MX3(p0[0], p0[1], p1[0]), tmb = MX3(p0[2], p0[3], p1[1]); tma = MX3(tma, p1[2], p1[3]);
#pragma unroll
        for (int r = 4; r < 16; r += 4) { tma = MX3(tma, p0[r], p0[r + 1]); tmb = MX3(tmb, p0[r + 2], p0[r + 3]); tma = MX3(tma, p1[r], p1[r + 1]); tmb = MX3(tmb, p1[r + 2], p1[r + 3]); }
        float tm = __builtin_fmaxf(tma, tmb);
        { auto rr = __builtin_amdgcn_permlane32_swap(__float_as_uint(tm), __float_as_uint(tm), false, false); tm = __builtin_fmaxf(__uint_as_float(rr[0]), __uint_as_float(rr[1])); }
#undef MX3
        if (__any(tm > m_ref + 8.0f)) {
            const float mnew = (tm > m_ref + 8.0f) ? tm : m_ref;
            const float sc = (mnew == m_ref) ? 1.f : __builtin_amdgcn_exp2f(m_ref - mnew);
            l_run *= sc;
#pragma unroll
            for (int r = 0; r < 16; ++r) { o[0][r] *= sc; o[1][r] *= sc; }
            m_ref = mnew;
        }
        f32x2_t ls2 = {0.f, 0.f}; const f32x2_t ms2 = {m_ref, m_ref};
#pragma unroll
        for (int r = 0; r < 16; r += 2) { f32x2_t a = (f32x2_t){p0[r], p0[r + 1]} - ms2, c = (f32x2_t){p1[r], p1[r + 1]} - ms2;
            a.x = __builtin_amdgcn_exp2f(a.x); a.y = __builtin_amdgcn_exp2f(a.y); c.x = __builtin_amdgcn_exp2f(c.x); c.y = __builtin_amdgcn_exp2f(c.y);
            p0[r] = a.x; p0[r + 1] = a.y; p1[r] = c.x; p1[r + 1] = c.y; ls2 += a; ls2 += c; }
        l_run += ls2.x + ls2.y;
    } else {
        float t0 = 1.f, t1 = 1.f;
        const bool dg = (64 * kt + 63 >= qw0);
#pragma unroll
        for (int r = 15; r >= 0; --r) {
            { const float e = __builtin_amdgcn_exp2f(-__builtin_fmaxf(p0[r], -100.f)), be = __builtin_amdgcn_rcpf(1.f + e); const bool v = !dg || (key0 + r < query);
              p0[r] = v ? be * t0 : 0.f; t0 = v ? t0 * (e * be) : t0; }
            { const float e = __builtin_amdgcn_exp2f(-__builtin_fmaxf(p1[r], -100.f)), be = __builtin_amdgcn_rcpf(1.f + e); const bool v = !dg || (key0 + 32 + r < query);
              p1[r] = v ? be * t1 : 0.f; t1 = v ? t1 * (e * be) : t1; }
        }
        float x0, x1;
        { auto rr = __builtin_amdgcn_permlane32_swap(__float_as_uint(t0), __float_as_uint(t0), false, false); x0 = hi ? __uint_as_float(rr[0]) : __uint_as_float(rr[1]); }
        { auto rr = __builtin_amdgcn_permlane32_swap(__float_as_uint(t1), __float_as_uint(t1), false, false); x1 = hi ? __uint_as_float(rr[0]) : __uint_as_float(rr[1]); }
        const float after1 = carry * (hi ? 1.f : x1), after0 = carry * t1 * x1 * (hi ? 1.f : x0);
#pragma unroll
        for (int r = 0; r < 16; ++r) { p0[r] *= after0; p1[r] *= after1; }
        carry *= (t0 * t1) * (x0 * x1);
        done = __all(carry == 0.f) != 0;
    }
    unsigned pw[16];
#pragma unroll
    for (int r = 0; r < 16; r += 2) { pw[r >> 1] = pk_bf16(p0[r], p0[r + 1]); pw[8 + (r >> 1)] = pk_bf16(p1[r], p1[r + 1]); }
    asm volatile("s_waitcnt lgkmcnt(0)" : "+v"(vr[0]), "+v"(vr[1]), "+v"(vr[2]), "+v"(vr[3]), "+v"(vr[4]), "+v"(vr[5]), "+v"(vr[6]), "+v"(vr[7]), "+v"(vr[8]), "+v"(vr[9]), "+v"(vr[10]), "+v"(vr[11]), "+v"(vr[12]), "+v"(vr[13]), "+v"(vr[14]), "+v"(vr[15]) :: "memory");
#pragma unroll
    for (int ps = 0; ps < 4; ++ps) { const bf16x8 pf = __builtin_bit_cast(bf16x8, (v4u){pw[4 * ps], pw[4 * ps + 1], pw[4 * ps + 2], pw[4 * ps + 3]});
        const bf16x8 vf0 = (bf16x8){vr[4 * ps][0], vr[4 * ps][1], vr[4 * ps][2], vr[4 * ps][3], vr[4 * ps + 1][0], vr[4 * ps + 1][1], vr[4 * ps + 1][2], vr[4 * ps + 1][3]};
        const bf16x8 vf1 = (bf16x8){vr[4 * ps + 2][0], vr[4 * ps + 2][1], vr[4 * ps + 2][2], vr[4 * ps + 2][3], vr[4 * ps + 3][0], vr[4 * ps + 3][1], vr[4 * ps + 3][2], vr[4 * ps + 3][3]};
        o[0] = MFMA32(vf0, pf, o[0]); o[1] = MFMA32(vf1, pf, o[1]); }
}
template <int MODE>
__device__ __forceinline__ void attn_pre(Frame& F, int l, const float* sinks, int b, int hk, int qb, int qi) {
    const bf16* P = (const bf16*)(F.ws + WS_PROJ); bf16* MX = (bf16*)(F.ws + WS_MIXED);
    LAS unsigned char* L = F.lds + RING_OFF;
    constexpr int SLOT = 16384, VOFF = 8192;
    LAS unsigned* FLG = (LAS unsigned*)(F.lds + LDSCTL_OFF + 64);
    const int lane = opaque_lane(), w = F.wave, iq = lane & 31, hi = lane >> 5;
    const int kcol = MODE == 0 ? COL_AK + 64 * hk : COL_CK + 64 * hk, vcol = MODE == 0 ? COL_AV + 64 * hk : COL_CV + 64 * hk;
    const size_t rowbase = (size_t)b * SEQ;
    const int q0 = 256 * qb, qw0 = q0 + 32 * w, query = qw0 + iq;
    const int drow = 8 * w + (lane >> 3), dch = lane & 7;
    const bf16* ksrc = P + (rowbase + drow) * NIN + kcol + 8 * (dch ^ ((drow >> 1) & 7));
    const bf16* vsrc = P + (rowbase + drow) * NIN + vcol + 8 * (dch ^ (((drow >> 1) & 1) << 2));
    int koff[4];
#pragma unroll
    for (int d0 = 0; d0 < 4; ++d0) koff[d0] = kimg(kperm(iq), 2 * d0 + hi);
    const int voff0 = VOFF + tr_lane_off(lane, 16 * hi, 0), voff1 = VOFF + tr_lane_off(lane, 16 * hi, 1);
#define PRE_DMA(kt_, slot_) do { const size_t o_ = (size_t)(kt_) * 64 * NIN; \
        __builtin_amdgcn_global_load_lds((const unsigned*)(ksrc + o_), (LAS unsigned*)(L + (slot_) * SLOT + w * 1024), 16, 0, 0); \
        __builtin_amdgcn_global_load_lds((const unsigned*)(vsrc + o_), (LAS unsigned*)(L + (slot_) * SLOT + VOFF + w * 1024), 16, 0, 0); } while (0)
    f32x16 o[2]; float m_ref = 0.f, l_run = 0.f, carry = (MODE == 2) ? 1.f : 0.f; bool done = false;
    if (MODE == 0) {
        const int kt_lo = qb > 0 ? 4 * qb - 2 : 0, nt = 4 * qb + 4 - kt_lo;
        for (int s = 0; s < nt; ++s) PRE_DMA(kt_lo + s, s);
        bf16x8 qfa[4], qfb[4];
#pragma unroll
        for (int d0 = 0; d0 < 4; ++d0) { qfa[d0] = *(const GAS bf16x8*)(P + (rowbase + query) * NIN + COL_AQ + 128 * hk + 16 * d0 + 8 * hi); qfb[d0] = *(const GAS bf16x8*)(P + (rowbase + query) * NIN + COL_AQ + 128 * hk + 64 + 16 * d0 + 8 * hi); }
        asm volatile("s_waitcnt vmcnt(0)" ::: "memory"); WG_BAR();
        unsigned tkA = 0u;
#pragma unroll
        for (int g = 0; g < 2; ++g) {
            const int h = 2 * hk + g;
            if (g == 1) { if (w == 0 && lane == 0) tkA = q_issue(F, qi); }
            m_ref = ((const GAS float*)sinks)[l * 4 + h] * 1.4426950408889634f; l_run = hi ? 0.f : 1.f;
#pragma unroll
            for (int r = 0; r < 16; ++r) { o[0][r] = 0.f; o[1][r] = 0.f; }
            for (int s = 0; s < nt; ++s) { const int kt = kt_lo + s;
                if ((64 * kt + 63 >= qw0 - 127) && (64 * kt <= qw0 + 31)) wave_tile<0>(L + s * SLOT, g ? qfb : qfa, koff, voff0, voff1, kt, qw0, query, hi, o, m_ref, l_run, carry, done); }
            const float inv = 1.0f / xsum32(l_run);
            bf16* op = MX + (rowbase + query) * DM + 64 * h + 4 * hi;
#pragma unroll
            for (int eb = 0; eb < 2; ++eb)
#pragma unroll
                for (int g4 = 0; g4 < 4; ++g4) { u32x2m ov; ov.x = pk_bf16(o[eb][4 * g4] * inv, o[eb][4 * g4 + 1] * inv); ov.y = pk_bf16(o[eb][4 * g4 + 2] * inv, o[eb][4 * g4 + 3] * inv);
                    *(GAS u32x2m*)(op + 32 * eb + 8 * g4) = ov; }
        }
        if (w == 0 && lane == 0) { Q_TAKE(tkA, 8); F.MISC[0] = tkA; }
        WG_BAR();
    } else {
        bf16x8 qf[4];
#pragma unroll
        for (int d0 = 0; d0 < 4; ++d0) qf[d0] = *(const GAS bf16x8*)(P + (rowbase + query) * NIN + COL_CQ + 64 * hk + 16 * d0 + 8 * hi);
#pragma unroll
        for (int r = 0; r < 16; ++r) { o[0][r] = 0.f; o[1][r] = 0.f; }
        for (int top = 4 * qb + 3; top >= 0; top -= 8) {
            const int nb = top + 1 < 8 ? top + 1 : 8;
            for (int s = 0; s < nb; ++s) PRE_DMA(top - s, s);
            asm volatile("s_waitcnt vmcnt(0)" ::: "memory"); WG_BAR();
            for (int s = 0; s < nb; ++s) { const int kt = top - s;
                if ((64 * kt <= qw0 + 30) && !done) wave_tile<2>(L + s * SLOT, qf, koff, voff0, voff1, kt, qw0, query, hi, o, m_ref, l_run, carry, done); }
            if (lane == 0) FLG[w] = (done || top - nb < 0) ? 1u : 0u;
            WG_BAR();
            const v4u f0 = *(const LAS v4u*)FLG, f1 = *(const LAS v4u*)(FLG + 4);
            if ((f0.x & f0.y & f0.z & f0.w & f1.x & f1.y & f1.z & f1.w) != 0u) break;
            WG_BAR();
        }
        const int lane_e = opaque_lane(), hi_e = lane_e >> 5;
        const bool qlead = (w == 0 && lane_e == 0); unsigned tk = 0u; if (qlead) tk = q_issue(F, qi);
        bf16* op = MX + ((size_t)b * SEQ + q0 + 32 * w + (lane_e & 31)) * DM + 512 + 64 * hk + 4 * hi_e;
#pragma unroll
        for (int eb = 0; eb < 2; ++eb)
#pragma unroll
            for (int g4 = 0; g4 < 4; ++g4) { u32x2m ov; ov.x = pk_bf16(o[eb][4 * g4], o[eb][4 * g4 + 1]); ov.y = pk_bf16(o[eb][4 * g4 + 2], o[eb][4 * g4 + 3]);
                *(GAS u32x2m*)(op + 32 * eb + 8 * g4) = ov; }
        if (qlead) { Q_TAKE(tk, 8); F.MISC[0] = tk; }
        WG_BAR();
    }
#undef PRE_DMA
}


constexpr size_t WS_PO2 = 848 * MiB;
constexpr size_t WS_PML2 = 976 * MiB;
constexpr size_t WS_LISTJ = 984 * MiB;
constexpr size_t WS_SEGC = 1000 * MiB;
constexpr size_t WS_END2 = 1001 * MiB;
#ifndef RR_REP
#define RR_REP 1
#endif
#ifndef RO_REP
#define RO_REP 1
#endif
#ifndef RS_REP
#define RS_REP 1
#endif
constexpr int CW_DEP = 24576;
constexpr unsigned DEP_SPIN_CAP = 1u << 22;
__device__ __forceinline__ void st_ag64(void* p, unsigned long long v) { __hip_atomic_store((GAS unsigned long long*)p, v, __ATOMIC_RELAXED, __HIP_MEMORY_SCOPE_AGENT); }
__device__ __forceinline__ void st_ag32(void* p, unsigned v) { __hip_atomic_store((GAS unsigned*)p, v, __ATOMIC_RELAXED, __HIP_MEMORY_SCOPE_AGENT); }
__device__ __forceinline__ unsigned long long ld_ag64(const void* p) { return __hip_atomic_load((GAS unsigned long long*)p, __ATOMIC_RELAXED, __HIP_MEMORY_SCOPE_AGENT); }
__device__ __forceinline__ unsigned ld_ag32(const void* p) { return __hip_atomic_load((GAS unsigned*)p, __ATOMIC_RELAXED, __HIP_MEMORY_SCOPE_AGENT); }
__device__ __forceinline__ void dep_wait(Frame& F, gu32* cnt, unsigned target, bool lead) {
    if (lead) { unsigned sp = 0; while (__hip_atomic_load((unsigned*)cnt, __ATOMIC_RELAXED, __HIP_MEMORY_SCOPE_AGENT) < target) { __builtin_amdgcn_s_sleep(2); if (++sp > DEP_SPIN_CAP) break; } }
    WG_BAR();
}
template <bool FENCE>
__device__ __forceinline__ void dep_post(Frame& F, gu32* cnt, bool lead) {
    asm volatile("s_waitcnt vmcnt(0)" ::: "memory"); WG_BAR();
    if (lead) { if (FENCE) { __builtin_amdgcn_fence(__ATOMIC_RELEASE, "agent"); asm volatile("s_waitcnt vmcnt(0)" ::: "memory"); }
        (void)__hip_atomic_fetch_add((unsigned*)cnt, 1u, __ATOMIC_RELAXED, __HIP_MEMORY_SCOPE_AGENT); }
}

__device__ __forceinline__ void moba_select(Frame& F, int l, int b, int qb, int qi, const bool last = true) {
    const bf16* P = (const bf16*)(F.ws + WS_PROJ);
    LAS unsigned char* L = F.lds + RING_OFF;
    constexpr int KMOFF = 69632, CTOFF = 65536;
    const int lane = opaque_lane(), w = F.wave, tid = w * 64 + lane, iq = lane & 31, hi = lane >> 5;
    const size_t rowbase = (size_t)b * SEQ;
    const int query = 256 * qb + 32 * w + iq;
    unsigned tk = 0u; if (tid == 0 && last) tk = q_issue(F, qi);
    bf16x8 qf[4][4];
#pragma unroll
    for (int h = 0; h < 4; ++h)
#pragma unroll
        for (int d0 = 0; d0 < 4; ++d0) qf[h][d0] = *(const GAS bf16x8*)(P + (rowbase + query) * NIN + COL_BQ + 64 * h + 16 * d0 + 8 * hi);
    for (int rep_ = 0; rep_ < RS_REP; ++rep_) {
    unsigned selmask[4];
    if (qb <= 3) {
#pragma unroll
        for (int h = 0; h < 4; ++h) selmask[h] = (1u << qb) - 1u;
    } else {
        { const int jj = tid >> 5, hh = (tid >> 3) & 3, ch = tid & 7;
          if (jj < qb) { const GAS f32x4* kp = (const GAS f32x4*)(F.ws + WS_KPART) + (size_t)(b * 16 + jj) * 128 + 16 * hh + 2 * ch;
              const f32x4 m0 = kp[0] + kp[64], m1 = kp[1] + kp[65];
              const unsigned h0 = pk_bf16(m0[0], m0[1]), h1 = pk_bf16(m0[2], m0[3]), h2 = pk_bf16(m1[0], m1[1]), h3 = pk_bf16(m1[2], m1[3]);
              const unsigned l0 = pk_bf16(m0[0] - bf_lo(h0), m0[1] - bf_hi(h0)), l1 = pk_bf16(m0[2] - bf_lo(h1), m0[3] - bf_hi(h1)), l2 = pk_bf16(m1[0] - bf_lo(h2), m1[1] - bf_hi(h2)), l3 = pk_bf16(m1[2] - bf_lo(h3), m1[3] - bf_hi(h3));
              *(LAS v4u*)(L + KMOFF + hh * 4096 + kimg(jj, ch)) = (v4u){h0, h1, h2, h3}; *(LAS v4u*)(L + KMOFF + hh * 4096 + kimg(16 + jj, ch)) = (v4u){l0, l1, l2, l3}; } }
        WG_BAR();
#pragma unroll
        for (int h = 0; h < 4; ++h) {
            f32x16 sc;
#pragma unroll
            for (int r = 0; r < 16; ++r) sc[r] = 0.f;
#pragma unroll
            for (int d0 = 0; d0 < 4; ++d0) sc = MFMA32(lds_row8(L + KMOFF + h * 4096 + kimg(kperm(iq), 2 * d0 + hi)), qf[h][d0], sc);
            float v1 = -INFINITY, v2 = -INFINITY, v3 = -INFINITY; int i1 = 0, i2 = 0, i3 = 0;
#pragma unroll
            for (int j = 0; j < 15; ++j) { const float g = xsum32(sc[j]);
                if (j < qb) { if (g > v1) { v3 = v2; i3 = i2; v2 = v1; i2 = i1; v1 = g; i1 = j; } else if (g > v2) { v3 = v2; i3 = i2; v2 = g; i2 = j; } else if (g > v3) { v3 = g; i3 = j; } } }
            selmask[h] = (1u << i1) | (1u << i2) | (1u << i3);
        }
    }
    LAS unsigned* CT = (LAS unsigned*)(L + CTOFF);
#pragma unroll
    for (int h = 0; h < 4; ++h)
        for (int j = 0; j < qb; ++j) { const unsigned long long bal = __ballot(((selmask[h] >> j) & 1u) != 0u && hi == 0); if (lane == 0) CT[(h * 16 + j) * 8 + w] = (unsigned)__popcll(bal); }
    WG_BAR();
#pragma unroll
    for (int h = 0; h < 4; ++h) {
        const int bh = b * 4 + h;
        for (int j = 0; j < qb; ++j) {
            const v4u c0 = *(const LAS v4u*)(CT + (h * 16 + j) * 8), c1 = *(const LAS v4u*)(CT + (h * 16 + j) * 8 + 4);
            const unsigned cw[8] = {c0.x, c0.y, c0.z, c0.w, c1.x, c1.y, c1.z, c1.w};
            unsigned woff = 0u, tot = 0u;
#pragma unroll
            for (int w2 = 0; w2 < 8; ++w2) { woff += (w2 < w) ? cw[w2] : 0u; tot += cw[w2]; }
            const bool sel = ((selmask[h] >> j) & 1u) != 0u;
            const unsigned long long bal = __ballot(sel && hi == 0);
            if (sel && hi == 0) {
                const unsigned pos = woff + (unsigned)__popcll(bal & ((1ull << iq) - 1ull));
                const unsigned rank = (unsigned)__popc(selmask[h] & ((1u << j) - 1u));
                __hip_atomic_store((GAS unsigned short*)(F.ws + WS_LISTJ + (((size_t)(bh * 16 + j) * 16 + qb) * 256 + pos) * 2), (unsigned short)((unsigned)(32 * w + iq) | (rank << 8)), __ATOMIC_RELAXED, __HIP_MEMORY_SCOPE_AGENT);
            }
            if (tid == 0) st_ag32(F.ws + WS_SEGC + ((size_t)(bh * 16 + j) * 64 + qb) * 4, tot);
        }
    }
    if (RS_REP > 1) WG_BAR();
    }
    dep_post<false>(F, F.ctl + CW_DEP + l * 4096, tid == 0 && last);
    if (tid == 0 && last) { Q_TAKE(tk, 0); F.MISC[0] = tk; }
    WG_BAR();
}

constexpr int NU_D = 32, NU_S = 240, NU_C = 1024, NU_R = 1024, NU_A = 512, NU_O = 256;
__device__ __forceinline__ void moba_routed_run(Frame& F, int l, int qi, int t0) {
    const bf16* P = (const bf16*)(F.ws + WS_PROJ);
    constexpr int SLOT = 16384, VOFF = 8192, R0 = NU_D + NU_S + NU_C;
    const int lane = opaque_lane(), w = F.wave, tid = w * 64 + lane, iq = lane & 31, hi = lane >> 5;
    const int drow = 8 * w + (lane >> 3), dch = lane & 7;
    const int kofs = 8 * (dch ^ ((drow >> 1) & 7)), vofs = 8 * (dch ^ (((drow >> 1) & 1) << 2));
    int koff[4];
#pragma unroll
    for (int d0 = 0; d0 < 4; ++d0) koff[d0] = kimg(kperm(iq), 2 * d0 + hi);
    const int voff0 = VOFF + tr_lane_off(lane, 16 * hi, 0), voff1 = VOFF + tr_lane_off(lane, 16 * hi, 1);
    volatile LAS unsigned* PL = (volatile LAS unsigned*)(F.lds + TAB_OFF + 16384 + 512);
    if (w == 0) PL[lane] = 0u;
    if (tid == 0 && F.MISC[2] != (unsigned)(l + 1)) { unsigned sp = 0; while (__hip_atomic_load((unsigned*)(F.ctl + CW_DEP + l * 4096), __ATOMIC_RELAXED, __HIP_MEMORY_SCOPE_AGENT) < 240u) { __builtin_amdgcn_s_sleep(2); if (++sp > DEP_SPIN_CAP) break; }
        F.MISC[2] = (unsigned)(l + 1); }
    WG_BAR();
#define RT_DMA(tr_, par_) do { const int b_ = ((tr_) & 63) >> 2, h_ = (tr_) & 3, j_ = (tr_) >> 6; \
        LAS unsigned char* Lh_ = F.lds + RING_OFF + (par_) * 65536; \
        const bf16* ks_ = P + ((size_t)b_ * SEQ + drow) * NIN + COL_BK + 64 * h_ + kofs; const bf16* vs_ = P + ((size_t)b_ * SEQ + drow) * NIN + COL_BV + 64 * h_ + vofs; \
        _Pragma("unroll") for (int s2 = 0; s2 < 4; ++s2) { const size_t o_ = (size_t)(4 * j_ + s2) * 64 * NIN; \
            __builtin_amdgcn_global_load_lds((const unsigned*)(ks_ + o_), (LAS unsigned*)(Lh_ + s2 * SLOT + w * 1024), 16, 0, 0); \
            __builtin_amdgcn_global_load_lds((const unsigned*)(vs_ + o_), (LAS unsigned*)(Lh_ + s2 * SLOT + VOFF + w * 1024), 16, 0, 0); } \
        const size_t sg_ = (size_t)((b_ * 4 + h_) * 16 + j_); \
        __builtin_amdgcn_global_load_lds((const unsigned*)(F.ws + WS_LISTJ + sg_ * 8192 + w * 1024 + lane * 16), (LAS unsigned*)(F.lds + TAB_OFF + (par_) * 8192 + w * 1024), 16, 0, 16); \
        if (w == 0) __builtin_amdgcn_global_load_lds((const unsigned*)(F.ws + WS_SEGC + (sg_ * 64 + lane) * 4), (LAS unsigned*)(F.lds + TAB_OFF + 16384 + (par_) * 256), 4, 0, 16); } while (0)
#define RT_STORE(rp_, pm_, valid_) do { const float lt_ = xsum32(l_run), inv_ = 1.0f / lt_; \
        _Pragma("unroll") for (int eb = 0; eb < 2; ++eb) _Pragma("unroll") for (int k2 = 0; k2 < 2; ++k2) { \
            const unsigned a0 = pk_bf16(o[eb][8 * k2] * inv_, o[eb][8 * k2 + 1] * inv_), a1 = pk_bf16(o[eb][8 * k2 + 2] * inv_, o[eb][8 * k2 + 3] * inv_); \
            const unsigned b0 = pk_bf16(o[eb][8 * k2 + 4] * inv_, o[eb][8 * k2 + 5] * inv_), b1 = pk_bf16(o[eb][8 * k2 + 6] * inv_, o[eb][8 * k2 + 7] * inv_); \
            const auto s0 = __builtin_amdgcn_permlane32_swap(a0, b0, false, false), s1 = __builtin_amdgcn_permlane32_swap(a1, b1, false, false); \
            if (valid_) *(GAS v4u*)((rp_) + 64 * eb + 32 * k2) = (v4u){s0[0], s1[0], s0[1], s1[1]}; } \
        if ((valid_) && hi == 0) *(GAS unsigned long long*)(pm_) = (unsigned long long)__float_as_uint(m_ref) | ((unsigned long long)__float_as_uint(lt_) << 32); } while (0)
    int tr = t0 - R0, par = 0;
    RT_DMA(tr, 0);
    unsigned tk = 0u; if (tid == 0) tk = q_issue(F, qi);
    for (;;) {
        asm volatile("s_waitcnt vmcnt(0)" ::: "memory");
        if (tid == 0) { asm volatile("" : "+v"(tk)); F.MISC[5 + par] = tk; }
        WG_BAR();
        const int tn = (int)F.MISC[5 + par], trn = tn - R0; const bool nxt = (trn >= 0 && trn < NU_R);
        const int b = (tr & 63) >> 2, h = tr & 3, j = tr >> 6, bh = b * 4 + h;
        if (tid == 0) PL[bh] = PL[bh] + 1u;
        const size_t rowbase = (size_t)b * SEQ;
        const LAS unsigned char* L = F.lds + RING_OFF + par * 65536;
        const LAS unsigned short* RAW = (const LAS unsigned short*)(F.lds + TAB_OFF + par * 8192);
        const LAS unsigned* CNT = (const LAS unsigned*)(F.lds + TAB_OFF + 16384 + par * 256);
        int cq[16]; int tot = 0;
        { const v4u c0 = *(const LAS v4u*)CNT, c1 = *(const LAS v4u*)(CNT + 4), c2 = *(const LAS v4u*)(CNT + 8), c3 = *(const LAS v4u*)(CNT + 12);
          const unsigned cc[16] = {c0.x, c0.y, c0.z, c0.w, c1.x, c1.y, c1.z, c1.w, c2.x, c2.y, c2.z, c2.w, c3.x, c3.y, c3.z, c3.w};
#pragma unroll
          for (int q = 0; q < 16; ++q) { cq[q] = (q > j) ? (int)(cc[q] & 0x1ffu) : 0; tot += cq[q]; } }
        const int ng = (tot + 31) >> 5;
#define RT_ENTRY(v_, e_) do { const int vv_ = (v_) < tot ? (v_) : tot - 1; int qs_ = 1, r_ = vv_, pe_ = 0; \
            _Pragma("unroll") for (int q = 1; q < 15; ++q) { pe_ += cq[q]; const bool ge_ = vv_ >= pe_; qs_ += ge_ ? 1 : 0; r_ -= ge_ ? cq[q] : 0; } \
            e_ = (unsigned)RAW[qs_ * 256 + r_] | ((unsigned)qs_ << 18); } while (0)
#define RT_LOADQ(dst_, e_) do { const bf16* qp_ = P + (rowbase + 256 * (int)((e_) >> 18) + (int)((e_) & 255u)) * NIN + COL_BQ + 64 * h + 8 * hi; \
            _Pragma("unroll") for (int d0 = 0; d0 < 4; ++d0) dst_[d0] = *(const GAS bf16x8*)(qp_ + 16 * d0); } while (0)
        const int qw0 = 256 * j + 32 * w, query = qw0 + iq;
        bf16x8 qf[4], nq0[4];
#pragma unroll
        for (int d0 = 0; d0 < 4; ++d0) { qf[d0] = *(const GAS bf16x8*)(P + (rowbase + query) * NIN + COL_BQ + 64 * h + 16 * d0 + 8 * hi); nq0[d0] = qf[d0]; }
        int g = (w + 7) & 7; unsigned e = 0u;
        if (g < ng) { RT_ENTRY(32 * g + iq, e); RT_LOADQ(nq0, e); }
        if (nxt) { RT_DMA(trn, par ^ 1); if (tid == 0) tk = q_issue(F, qi); }
        {
            f32x16 o[2]; float m_ref = -INFINITY, l_run = 0.f, carry = 0.f; bool done = false;
#pragma unroll
            for (int r = 0; r < 16; ++r) { o[0][r] = 0.f; o[1][r] = 0.f; }
#pragma unroll 1
            for (int s2 = 0; s2 < 4; ++s2) { const int kt = 4 * j + s2; if (64 * kt <= qw0 + 31) wave_tile<1>(L + s2 * SLOT, qf, koff, voff0, voff1, kt, qw0, query, hi, o, m_ref, l_run, carry, done, 64 * kt + 63 > qw0); }
            const size_t prow = ((size_t)bh * SEQ + query) * 4 + 3;
            unsigned char* rp = F.ws + WS_PO2 + prow * 128 + 16 * hi;
            RT_STORE(rp, F.ws + WS_PML2 + prow * 8, true);
        }
#pragma unroll
        for (int d0 = 0; d0 < 4; ++d0) qf[d0] = nq0[d0];
        while (g < ng) {
            const int gn = g + 8; unsigned en = e;
            bf16x8 nq[4];
#pragma unroll
            for (int d0 = 0; d0 < 4; ++d0) nq[d0] = qf[d0];
            if (gn < ng) { RT_ENTRY(32 * gn + iq, en); RT_LOADQ(nq, en); }
            f32x16 o[2]; float m_ref = -INFINITY, l_run = 0.f, carry = 0.f; bool done = false;
#pragma unroll
            for (int r = 0; r < 16; ++r) { o[0][r] = 0.f; o[1][r] = 0.f; }
#pragma unroll 1
            for (int s2 = 0; s2 < 4; ++s2) wave_tile<1>(L + s2 * SLOT, qf, koff, voff0, voff1, 4 * j + s2, 0, 0, hi, o, m_ref, l_run, carry, done, false);
            const size_t prow = ((size_t)bh * SEQ + 256 * (int)(e >> 18) + (int)(e & 255u)) * 4 + ((e >> 8) & 3u);
            const bool valid = 32 * g + iq < tot;
            unsigned char* rp = F.ws + WS_PO2 + prow * 128 + 16 * hi;
            RT_STORE(rp, F.ws + WS_PML2 + prow * 8, valid);
#pragma unroll
            for (int d0 = 0; d0 < 4; ++d0) qf[d0] = nq[d0];
            g = gn; e = en;
        }
#undef RT_ENTRY
#undef RT_LOADQ
        if (!nxt) { if (tid == 0) F.MISC[0] = (unsigned)tn; break; }
        tr = trn; par ^= 1;
    }
#undef RT_DMA
#undef RT_STORE
    asm volatile("s_waitcnt vmcnt(0)" ::: "memory"); WG_BAR();
    if (w == 0) { __builtin_amdgcn_fence(__ATOMIC_RELEASE, "agent"); asm volatile("s_waitcnt vmcnt(0)" ::: "memory");
        const unsigned c = PL[lane];
        if (c) (void)__hip_atomic_fetch_add((unsigned*)(F.ctl + CW_DEP + l * 4096 + 64 + 16 * lane), c, __ATOMIC_RELAXED, __HIP_MEMORY_SCOPE_AGENT); }
}

__device__ __forceinline__ void moba_merge(Frame& F, int l, int b, int qb, int qi, const bool last = true) {
    bf16* MX = (bf16*)(F.ws + WS_MIXED);
    const int lane = opaque_lane(), w = F.wave, c8 = lane & 7, ql = lane >> 3;
    const bool qlead = (w == 0 && lane == 0); unsigned tk = 0u; if (qlead && last) tk = q_issue(F, qi);
    if (qlead) { for (int h = 0; h < 4; ++h) { unsigned sp = 0; while (__hip_atomic_load((unsigned*)(F.ctl + CW_DEP + l * 4096 + 64 + 16 * (b * 4 + h)), __ATOMIC_RELAXED, __HIP_MEMORY_SCOPE_AGENT) < 16u) { __builtin_amdgcn_s_sleep(2); if (++sp > DEP_SPIN_CAP) break; } }
        __builtin_amdgcn_fence(__ATOMIC_ACQUIRE, "agent"); asm volatile("s_waitcnt vmcnt(0)" ::: "memory"); }
    WG_BAR();
    const int nsel = qb < 3 ? qb : 3;
    const int qbase = 256 * qb + 32 * w + ql;
#pragma unroll
    for (int h = 0; h < 4; ++h) {
        const int bh = b * 4 + h;
        unsigned long long ml[4][4]; v4u pv[4][4];
#pragma unroll
        for (int p = 0; p < 4; ++p) { const int query = qbase + 8 * p; const size_t rec = ((size_t)bh * SEQ + query) * 4;
#pragma unroll
            for (int r = 0; r < 4; ++r) { const int slot = ((r == 3) || (r < nsel)) ? r : 3;
                ml[p][r] = *(const GAS unsigned long long*)(F.ws + WS_PML2 + (rec + slot) * 8); pv[p][r] = *(const GAS v4u*)(F.ws + WS_PO2 + (rec + slot) * 128 + 16 * c8); } }
#pragma unroll
        for (int p = 0; p < 4; ++p) { const int query = qbase + 8 * p;
            float mr[4], lr[4]; float mstar = -INFINITY;
#pragma unroll
            for (int r = 0; r < 4; ++r) { const bool use = (r == 3) || (r < nsel); mr[r] = __uint_as_float((unsigned)ml[p][r]); lr[r] = use ? __uint_as_float((unsigned)(ml[p][r] >> 32)) : 0.f; if (use) mstar = __builtin_fmaxf(mstar, mr[r]); }
            float o[8]; float lsum = 0.f;
#pragma unroll
            for (int c = 0; c < 8; ++c) o[c] = 0.f;
#pragma unroll
            for (int r = 0; r < 4; ++r) {
                const bool use = (r == 3) || (r < nsel);
                const float wr = use ? lr[r] * __builtin_amdgcn_exp2f(mr[r] - mstar) : 0.f;
#pragma unroll
                for (int c = 0; c < 4; ++c) { const unsigned u = pv[p][r][c]; o[2 * c] += wr * bf_lo(u); o[2 * c + 1] += wr * bf_hi(u); }
                lsum += wr;
            }
            const float inv = 1.0f / lsum;
            v4u ov; ov.x = pk_bf16(o[0] * inv, o[1] * inv); ov.y = pk_bf16(o[2] * inv, o[3] * inv); ov.z = pk_bf16(o[4] * inv, o[5] * inv); ov.w = pk_bf16(o[6] * inv, o[7] * inv);
            *(GAS v4u*)(MX + ((size_t)b * SEQ + query) * DM + 256 + 64 * h + 8 * c8) = ov; }
    }
    if (qlead && last) { Q_TAKE(tk, 0); F.MISC[0] = tk; }
    WG_BAR();
}

#ifndef REPU_S
#define REPU_S 1
#endif
#ifndef REPU_R
#define REPU_R 1
#endif
#ifndef REPU_M
#define REPU_M 1
#endif
constexpr int NU_E = 256;
__device__ __forceinline__ void mixer_phase(Frame& F, int qi, int l, const float* sinks, const WPtrs& W) {
    if (F.wave == 0 && opaque_lane() == 0) F.MISC[0] = Q_FETCH(true);
    WG_BAR();
    for (;;) {
        int t = (int)F.MISC[0]; const int traw = t;
        if (t < NU_D) { ret_chain2(F, t >> 1, t & 1); if (F.wave == 0 && opaque_lane() == 0) F.MISC[0] = Q_FETCH(true); WG_BAR(); continue; } t -= NU_D;
        if (t < NU_S) { for (int rr = 0; rr < REPU_S; ++rr) moba_select(F, l, t & 15, 1 + (t >> 4), qi, rr == REPU_S - 1); continue; } t -= NU_S;
        if (t < NU_C) { attn_pre<2>(F, l, sinks, (t & 63) >> 2, t & 3, 15 - (t >> 6), qi); continue; } t -= NU_C;
        if (t < NU_R) { moba_routed_run(F, l, qi, traw); continue; } t -= NU_R;
        if (t < NU_A + NU_O) { const int k3 = t / 3, r3 = t - 3 * k3;
            if (r3 < 2) { const int ta = 2 * k3 + r3; attn_pre<0>(F, l, sinks, (ta & 31) >> 1, ta & 1, 15 - (ta >> 5), qi); }
            else { for (int rr = 0; rr < REPU_M; ++rr) moba_merge(F, l, k3 & 15, 15 - (k3 >> 4), qi, rr == REPU_M - 1); }
            continue; } t -= NU_A + NU_O;
        if (l == 0 && DEPTH > 1 && t < NU_E) { LAS float* scr = (LAS float*)(F.lds + RING_OFF + F.wave * 16384); const int ln = opaque_lane();
            unsigned tk = 0u; if (F.wave == 0 && ln == 0) tk = q_issue(F, qi);
            for (int k = 0; k < PER_L / (NU_E * NWAVES); ++k) weight_item(F, W, 1, t * (PER_L / NU_E) + F.wave + NWAVES * k, scr, ln);
            WG_BAR(); if (F.wave == 0 && ln == 0) { Q_TAKE(tk, 0); F.MISC[0] = tk; } WG_BAR(); continue; }
        break;
    }
}

#ifndef GEMM_ALIGN
#define GEMM_ALIGN true
#endif
#ifndef GEMM_SP2
#define GEMM_SP2 true
#endif
#ifndef REP_IN
#define REP_IN 1
#endif
#ifndef REP_MIX
#define REP_MIX 1
#endif
#ifndef REP_OUT
#define REP_OUT 1
#endif
#ifndef REP_UP
#define REP_UP 1
#endif
#ifndef REP_DN
#define REP_DN 1
#endif

#ifndef EN_IN
#define EN_IN 1
#endif
#ifndef EN_MIX
#define EN_MIX 1
#endif
#ifndef EN_OUT
#define EN_OUT 1
#endif
#ifndef EN_UP
#define EN_UP 1
#endif
#ifndef EN_DN
#define EN_DN 1
#endif
#ifndef EN_P0
#define EN_P0 1
#endif
#ifndef EN_FIN
#define EN_FIN 1
#endif

struct Args { const float* in[10]; float* out; unsigned char* ws; int ph_lo, ph_hi, pad0, pad1; };
__global__ void __launch_bounds__(NWAVES * 64, 2) hymba_fwd(Args args) {
    extern __shared__ __attribute__((aligned(16))) unsigned char lds[];
    Frame F;
    F.lds = (LAS unsigned char*)lds;
    F.MISC = (volatile LAS unsigned*)(F.lds + MISC_OFF);
    F.tid = threadIdx.x; F.lane = F.tid & 63; F.wave = __builtin_amdgcn_readfirstlane(F.tid >> 6);
    F.G = gridDim.x; { const int bx = blockIdx.x; F.vcu = (F.G % 8 == 0) ? (bx % 8) * (F.G / 8) + bx / 8 : bx; }
    F.ws = args.ws; F.ctl = (gu32*)(args.ws + WS_CTL);
    for (int u = F.tid; u < (LDS_BYTES - LDSCTL_OFF) / 4; u += NWAVES * 64) ((LAS unsigned*)(F.lds + LDSCTL_OFF))[u] = 0u;
    __syncthreads();
    XcdBarrier bar; bar.bar = (unsigned*)(F.ctl + CW_BAR); bar.x = 0; bar.st = nullptr;
    if (MK_ONE_LAUNCH) bar = xcd_barrier_post((unsigned*)(F.ctl + CW_BAR), F.MISC + 8);
#if MK_ONE_LAUNCH
    int lo = 0, hi = N_PHASES;
#else
    int lo = args.ph_lo, hi = args.ph_hi;
#endif
#define IN(k) (lo <= (k) && (k) < hi)
#define SEAM(k) do { if (IN(k) && IN((k) + 1)) { LAUNDER(); bar.bar = (unsigned*)(F.ctl + CW_BAR); asm volatile("" : "+s"(bar.x)); xcd_barrier(bar, F.wave == 0 && opaque_lane() == 0); } LAUNDER(); } while (0)
#define LAUNDER() do { asm volatile("" : "+s"(F.wave), "+s"(F.ws), "+s"(F.vcu), "+s"(F.G)); if (!MK_ONE_LAUNCH) asm volatile("" : "+s"(lo), "+s"(hi)); F.lane = opaque_lane(); F.tid = F.wave * 64 + F.lane; F.ctl = (gu32*)(F.ws + WS_CTL); } while (0)

#ifndef REP_P0
#define REP_P0 1
#endif
#ifndef REP_FIN
#define REP_FIN 1
#endif
    for (int rep = 0; rep < REP_P0; ++rep) { if (rep) { LAUNDER(); bar.bar = (unsigned*)(F.ctl + CW_BAR); asm volatile("" : "+s"(bar.x)); xcd_barrier(bar, F.wave == 0 && opaque_lane() == 0); LAUNDER(); }
    if (IN(0) && EN_P0) { const WPtrs W{0}; p0_prologue(F, karg(KA_X), W); } } SEAM(0);

    for (int l_ = 0; l_ < DEPTH; ++l_) { int l = l_;
        asm volatile("" : "+s"(l)); const int pb = 1 + 5 * l;
        for (int rep = 0; rep < REP_IN; ++rep) { if (rep) { LAUNDER(); bar.bar = (unsigned*)(F.ctl + CW_BAR); asm volatile("" : "+s"(bar.x)); xcd_barrier(bar, F.wave == 0 && opaque_lane() == 0); LAUNDER(); }
        if (IN(pb) && EN_IN) {
            pg8::Gemm g{(const bf16*)(F.ws + WS_XB), w_in_t(F, l), M, NIN, DM}; pg8::StaticOrder S; { int bx_ = (int)blockIdx.x; asm volatile("" : "+s"(bx_)); S.init(M, NIN, F.G, bx_); }
            pg8::Unit u0; const bool hu = S.next(0, u0); const int pm0 = hu ? u0.pm : 0, pn0 = hu ? u0.pn : 0;
            { const float* vec = (const float*)(F.ws + WS_VEC); build_vec_table(F, vec + VEC_CSIN + l * NIN, vec + VEC_BBIN + l * NIN, 0.f, 0.f, pn0, NIN / 256); }
            build_row_table(F, l ? st_buf(F, l - 1, 1) : nullptr, pm0);
            pg8::EpiIn E{F.ws, l, pm0, pn0};
            pg8::gemm_phase<pg8::EpiIn, pg8::StaticOrder, GEMM_ALIGN, GEMM_SP2>(F.lds + RING_OFF, g, S, E, F.wave);
        } }
        SEAM(pb);
        for (int rep = 0; rep < REP_MIX; ++rep) { if (rep) { LAUNDER(); bar.bar = (unsigned*)(F.ctl + CW_BAR); asm volatile("" : "+s"(bar.x)); xcd_barrier(bar, F.wave == 0 && opaque_lane() == 0); LAUNDER(); }
        if (IN(pb + 1) && EN_MIX) {
            if (l == 0) finalize_vecs(F, 0);
            const WPtrs W{0};
            mixer_phase(F, l + 2 * rep, l, karg(KA_SINKS), W);
        } }
        SEAM(pb + 1);
        for (int rep = 0; rep < REP_OUT; ++rep) { if (rep) { LAUNDER(); bar.bar = (unsigned*)(F.ctl + CW_BAR); asm volatile("" : "+s"(bar.x)); xcd_barrier(bar, F.wave == 0 && opaque_lane() == 0); LAUNDER(); }
        if (IN(pb + 2) && EN_OUT) {
            if (l == 0) finalize_vecs(F, 1);
            pg8::Gemm g{(const bf16*)(F.ws + WS_MIXED), w_out_t(F, l), M, DM, DM}; pg8::StaticOrder S; { int bx_ = (int)blockIdx.x; asm volatile("" : "+s"(bx_)); S.init(M, DM, F.G, bx_); }
            pg8::Unit u0; const bool hu = S.next(0, u0); const int pm0 = hu ? u0.pm : 0, pn0 = hu ? u0.pn : 0;
            build_vec_table(F, l ? karg(KA_LN2W) + (l - 1) * DM : nullptr, l ? karg(KA_LN2B) + (l - 1) * DM : nullptr, 1.f, 0.f, pn0, DM / 256);
            build_row_table(F, l ? st_buf(F, l - 1, 1) : nullptr, pm0);
            pg8::EpiRes E{F.ws, l ? 1 : 0, (int)(WS_XB >> 20), (int)(WS_Y1 >> 20), (int)(WS_ST >> 20) + 2 * (2 * l), pm0, pn0};
            pg8::gemm_phase<pg8::EpiRes, pg8::StaticOrder, true, GEMM_SP2>(F.lds + RING_OFF, g, S, E, F.wave);
        } }
        SEAM(pb + 2);
        for (int rep = 0; rep < REP_UP; ++rep) { if (rep) { LAUNDER(); bar.bar = (unsigned*)(F.ctl + CW_BAR); asm volatile("" : "+s"(bar.x)); xcd_barrier(bar, F.wave == 0 && opaque_lane() == 0); LAUNDER(); }
        if (IN(pb + 3) && EN_UP) {
#ifdef PROBE_SLEEP_US
            { const unsigned long long t0_ = __builtin_amdgcn_s_memrealtime(); while (__builtin_amdgcn_s_memrealtime() - t0_ < (unsigned long long)PROBE_SLEEP_US * 100ull) __builtin_amdgcn_s_sleep(64); }
#endif
            pg8::Gemm g{(const bf16*)(F.ws + WS_Y1), w_up_t(F, l), M, FF, DM}; pg8::StaticOrder S; { int bx_ = (int)blockIdx.x; asm volatile("" : "+s"(bx_)); S.init(M, FF, F.G, bx_); }
            pg8::Unit u0; const bool hu = S.next(0, u0); const int pm0 = hu ? u0.pm : 0, pn0 = hu ? u0.pn : 0;
            { const float* vec = (const float*)(F.ws + WS_VEC); build_vec_table(F, vec + VEC_CSUP + l * FF, vec + VEC_BBUP + l * FF, 0.f, 0.f, pn0, FF / 256); }
            build_row_table(F, st_buf(F, l, 0), pm0);
            pg8::EpiUp E{F.ws, l, pm0, pn0};
            pg8::gemm_phase<pg8::EpiUp, pg8::StaticOrder, GEMM_ALIGN, GEMM_SP2>(F.lds + RING_OFF, g, S, E, F.wave);
        } }
        SEAM(pb + 3);
        for (int rep = 0; rep < REP_DN; ++rep) { if (rep) { LAUNDER(); bar.bar = (unsigned*)(F.ctl + CW_BAR); asm volatile("" : "+s"(bar.x)); xcd_barrier(bar, F.wave == 0 && opaque_lane() == 0); LAUNDER(); }
        if (IN(pb + 4) && EN_DN) {
            pg8::Gemm g{(const bf16*)(F.ws + WS_HID), w_down_t(F, l), M, DM, FF}; pg8::StaticOrder S; { int bx_ = (int)blockIdx.x; asm volatile("" : "+s"(bx_)); S.init(M, DM, F.G, bx_); }
            pg8::Unit u0; const bool hu = S.next(0, u0); const int pm0 = hu ? u0.pm : 0, pn0 = hu ? u0.pn : 0;
            build_vec_table(F, karg(KA_LN1W) + l * DM, karg(KA_LN1B) + l * DM, 1.f, 0.f, pn0, DM / 256);
            build_row_table(F, st_buf(F, l, 0), pm0);
            pg8::EpiRes E{F.ws, 1, (int)(WS_Y1 >> 20), (int)(WS_XB >> 20), (int)(WS_ST >> 20) + 2 * (2 * l + 1), pm0, pn0};
            pg8::gemm_phase<pg8::EpiRes, pg8::StaticOrder, true, GEMM_SP2>(F.lds + RING_OFF, g, S, E, F.wave);
        } }
        SEAM(pb + 4);
    }
    for (int rep = 0; rep < REP_FIN; ++rep) { if (rep) { LAUNDER(); bar.bar = (unsigned*)(F.ctl + CW_BAR); asm volatile("" : "+s"(bar.x)); xcd_barrier(bar, F.wave == 0 && opaque_lane() == 0); LAUNDER(); }
    if (IN(11) && EN_FIN) final_ln(F, args.out, (const bf16*)(F.ws + WS_XB), st_buf(F, DEPTH - 1, 1), karg(KA_LN2W) + (DEPTH - 1) * DM, karg(KA_LN2B) + (DEPTH - 1) * DM); }
#undef IN
#undef SEAM
}

extern "C" void kernel_launch(void* const* d_in, const int* in_sizes, int n_in, void* d_out, int out_size, void* d_ws, size_t ws_size, hipStream_t stream) {
    static int grid = 0;
    if (grid == 0) {
        if (n_in != 10 || in_sizes[0] != M * DM || out_size != M * DM || ws_size < WS_END) { fprintf(stderr, "kernel_launch: unexpected shapes (n_in %d, in0 %d, out %d, ws %zu); nothing launched\n", n_in, n_in > 0 ? in_sizes[0] : -1, out_size, ws_size); grid = -1; return; }
        int dev = 0, cus = 0, per_cu = 0;
        if (hipGetDevice(&dev) != hipSuccess || hipDeviceGetAttribute(&cus, hipDeviceAttributeMultiprocessorCount, dev) != hipSuccess) { grid = -1; return; }
        if (hipFuncSetAttribute((const void*)hymba_fwd, hipFuncAttributeMaxDynamicSharedMemorySize, LDS_BYTES) != hipSuccess) { fprintf(stderr, "kernel_launch: hipFuncSetAttribute failed\n"); grid = -1; return; }
        if (hipOccupancyMaxActiveBlocksPerMultiprocessor(&per_cu, (const void*)hymba_fwd, NWAVES * 64, LDS_BYTES) != hipSuccess || per_cu < 1)
            fprintf(stderr, "kernel_launch: note: occupancy query reports %d workgroups per CU\n", per_cu);
        (void)hipGetLastError();
        grid = cus;
    }
    if (grid < 0) return;
    if (hipMemsetAsync((char*)d_ws + WS_CTL, 0, CTL_ZERO_BYTES, stream) != hipSuccess) return;
    Args a{};
    for (int i = 0; i < 10; ++i) a.in[i] = (const float*)d_in[i];
    a.out = (float*)d_out; a.ws = (unsigned char*)d_ws; a.pad0 = 0; a.pad1 = 0;
#if MK_ONE_LAUNCH
    a.ph_lo = 0; a.ph_hi = N_PHASES;
    hipLaunchKernelGGL(hymba_fwd, dim3(grid), dim3(NWAVES * 64), LDS_BYTES, stream, a);
#else
    for (int p = 0; p < N_PHASES; ++p) { a.ph_lo = p; a.ph_hi = p + 1; hipLaunchKernelGGL(hymba_fwd, dim3(grid), dim3(NWAVES * 64), LDS_BYTES, stream, a); }
#endif
}
```
